# Optimizing an MI355X kernel written in HIP

```python
import math
import jax, jax.numpy as jnp
from jax import lax
import numpy as np

D_MODEL = 1024
BATCH = 8
SEQ = 8192
DEPTH = 2

N_MIXERS = 2
DA_HEAD_DIM = 64
DA_HEADS = D_MODEL // (2 * DA_HEAD_DIM)
DA_QK_WIDTH = 2 * DA_HEADS * DA_HEAD_DIM
DA_V_WIDTH = DA_HEADS * 2 * DA_HEAD_DIM
Q_BLOCK = 128
ROPE_THETA = 10000.0
SG_CHUNK = 128
SG_GROUPS = 8
SG_HALF = 2 * D_MODEL
SG_GROUP_DIM = SG_HALF // SG_GROUPS
N_EXPERTS = 64
TOP_K = 6
N_EXPERT_GROUPS = 8
TOPK_GROUPS = 4
EXPERT_DIM = D_MODEL // 4
SHARED_DIM = EXPERT_DIM
ROUTED_SCALE = 2.5
MOE_BLOCK = 128
EPS = 1e-6

N_DA_LAYERS = (DEPTH + 1) // 2
N_SG_LAYERS = DEPTH // 2

kernel_name = "hybrid_diffattn_chunkgmlp_moe_adaln"


def rms_norm(x, g):
    xf = x.astype(jnp.float32)
    y = xf * lax.rsqrt(jnp.mean(xf * xf, axis=-1, keepdims=True) + EPS)
    return (y * g.astype(jnp.float32)).astype(x.dtype)


def layer_norm(x, g, b):
    xf = x.astype(jnp.float32)
    mu = jnp.mean(xf, axis=-1, keepdims=True)
    xc = xf - mu
    y = xc * lax.rsqrt(jnp.mean(xc * xc, axis=-1, keepdims=True) + EPS)
    return (y * g.astype(jnp.float32) + b.astype(jnp.float32)).astype(x.dtype)


def modulate(h, shift, scale):
    return h * (1 + scale[:, None, :]) + shift[:, None, :]


def apply_rope(x, cos, sin):
    x1, x2 = jnp.split(x, 2, axis=-1)
    c = cos[:, :, None, :]
    s = sin[:, :, None, :]
    return jnp.concatenate([x1 * c - x2 * s, x2 * c + x1 * s], axis=-1)


def diff_attention(h, positions, w_in, lam_q1, lam_k1, lam_q2, lam_k2, subln_g, w_out, lambda_init):
    B, S, _ = h.shape
    H, d = DA_HEADS, DA_HEAD_DIM
    qkv = h @ w_in
    q, k, v = jnp.split(qkv, [DA_QK_WIDTH, 2 * DA_QK_WIDTH], axis=-1)
    q = q.reshape(B, S, 2 * H, d)
    k = k.reshape(B, S, 2 * H, d)
    v = v.reshape(B, S, H, 2 * d)
    inv_freq = ROPE_THETA ** (-jnp.arange(0, d, 2, dtype=jnp.float32) / d)
    ang = positions.astype(jnp.float32)[..., None] * inv_freq
    cos = jnp.cos(ang).astype(h.dtype)
    sin = jnp.sin(ang).astype(h.dtype)
    q = apply_rope(q, cos, sin) * (d ** -0.5)
    k = apply_rope(k, cos, sin)
    f32 = jnp.float32
    lam = (jnp.exp(jnp.sum(lam_q1.astype(f32) * lam_k1.astype(f32)))
           - jnp.exp(jnp.sum(lam_q2.astype(f32) * lam_k2.astype(f32))) + lambda_init)
    nqb = S // Q_BLOCK
    qb = q.reshape(B, nqb, Q_BLOCK, 2 * H, d).transpose(1, 0, 2, 3, 4)

    def block(q_blk):
        s = jnp.einsum('bqhd,bkhd->bhqk', q_blk, k, preferred_element_type=jnp.float32)
        p = jax.nn.softmax(s, axis=-1).reshape(B, H, 2, Q_BLOCK, S)
        a = (p[:, :, 0] - lam * p[:, :, 1]).astype(v.dtype)
        return jnp.einsum('bhqk,bkhe->bqhe', a, v)

    o = lax.map(block, qb)
    o = o.transpose(1, 0, 2, 3, 4).reshape(B, S, H, 2 * d)
    o = rms_norm(o, subln_g) * (1.0 - lambda_init)
    return o.reshape(B, S, H * 2 * d) @ w_out


def chunked_spatial_gating(h, w_in, ln_g, ln_b, w_s, b_s, w_out):
    B, S, _ = h.shape
    z = jax.nn.gelu(h @ w_in, approximate=False)
    u, v = jnp.split(z, 2, axis=-1)
    v = layer_norm(v, ln_g, ln_b)
    n = S // SG_CHUNK
    v = v.reshape(B, n, SG_CHUNK, SG_GROUPS, SG_GROUP_DIM)
    s = jnp.einsum('gpq,bnqgc->bnpgc', w_s, v) + b_s.T[None, None, :, :, None]
    return (u * s.reshape(B, S, SG_HALF)) @ w_out


def moe(h, w_router, router_bias, w_gate, w_up, w_down, ws_gate, ws_up, ws_down):
    B, S, D = h.shape
    T = B * S
    xf = h.reshape(T, D)
    logits = jnp.dot(xf, w_router, preferred_element_type=jnp.float32)
    scores = jax.nn.sigmoid(logits)
    sel = scores + router_bias.astype(jnp.float32)
    grp = sel.reshape(T, N_EXPERT_GROUPS, N_EXPERTS // N_EXPERT_GROUPS)
    grp_score = jnp.sum(lax.top_k(grp, 2)[0], axis=-1)
    _, gidx = lax.top_k(grp_score, TOPK_GROUPS)
    gmask = jnp.sum(jax.nn.one_hot(gidx, N_EXPERT_GROUPS, dtype=jnp.float32), axis=1) > 0
    emask = jnp.repeat(gmask, N_EXPERTS // N_EXPERT_GROUPS, axis=1)
    _, eidx = lax.top_k(jnp.where(emask, sel, -jnp.inf), TOP_K)
    wts = jnp.take_along_axis(scores, eidx, axis=1)
    wts = wts / jnp.sum(wts, axis=-1, keepdims=True) * ROUTED_SCALE
    TK = T * TOP_K
    flat_e = eidx.reshape(TK)
    flat_tok = jnp.arange(TK, dtype=jnp.int32) // TOP_K
    flat_w = wts.reshape(TK).astype(h.dtype)
    order = jnp.argsort(flat_e)
    se = flat_e[order]
    counts = jnp.bincount(flat_e, length=N_EXPERTS)
    padded = (counts + MOE_BLOCK - 1) // MOE_BLOCK * MOE_BLOCK
    pad_end = jnp.cumsum(padded)
    pad_start = pad_end - padded
    start = jnp.cumsum(counts) - counts
    dest = pad_start[se] + jnp.arange(TK, dtype=jnp.int32) - start[se]
    nb = TK // MOE_BLOCK + N_EXPERTS
    P = nb * MOE_BLOCK
    buf_tok = jnp.zeros((P,), jnp.int32).at[dest].set(flat_tok[order])
    buf_w = jnp.zeros((P,), h.dtype).at[dest].set(flat_w[order])
    block_e = jnp.minimum(
        jnp.searchsorted(pad_end, jnp.arange(nb, dtype=pad_end.dtype) * MOE_BLOCK, side='right'),
        N_EXPERTS - 1)
    y0 = (jax.nn.silu(xf @ ws_gate) * (xf @ ws_up)) @ ws_down

    def step(y, blk):
        tok, e, w = blk
        xb = xf[tok]
        hb = jax.nn.silu(xb @ w_gate[e]) * (xb @ w_up[e])
        return y.at[tok].add((hb @ w_down[e]) * w[:, None]), None

    y, _ = lax.scan(step, y0, (buf_tok.reshape(nb, MOE_BLOCK), block_e,
                               buf_w.reshape(nb, MOE_BLOCK)))
    return y.reshape(B, S, D)


def setup_inputs(seed: int = 0) -> dict:
    key = jax.random.key(seed)
    ks = iter(jax.random.split(key, 32))
    nrm = lambda shape, s: jax.random.normal(next(ks), shape, jnp.float32) * s
    D, E, F = D_MODEL, N_EXPERTS, EXPERT_DIM
    NA, NS = N_DA_LAYERS, N_SG_LAYERS
    return {
        "x": nrm((BATCH, SEQ, D), 1.0),
        "c": nrm((BATCH, D), 1.0),
        "positions": jnp.broadcast_to(jnp.arange(SEQ, dtype=jnp.int32), (BATCH, SEQ)),
        "norm1_g": 1.0 + nrm((DEPTH, D), 0.02),
        "norm2_g": 1.0 + nrm((DEPTH, D), 0.02),
        "ada_w": nrm((DEPTH, D, 6 * D), 0.5 * D ** -0.5),
        "ada_b": nrm((DEPTH, 6 * D), 0.02),
        "da_w_in": nrm((NA, D, 2 * DA_QK_WIDTH + DA_V_WIDTH), D ** -0.5),
        "da_lam_q1": nrm((NA, DA_HEAD_DIM), 0.1),
        "da_lam_k1": nrm((NA, DA_HEAD_DIM), 0.1),
        "da_lam_q2": nrm((NA, DA_HEAD_DIM), 0.1),
        "da_lam_k2": nrm((NA, DA_HEAD_DIM), 0.1),
        "da_subln_g": 1.0 + nrm((NA, 2 * DA_HEAD_DIM), 0.02),
        "da_w_out": nrm((NA, DA_V_WIDTH, D), DA_V_WIDTH ** -0.5),
        "sg_w_in": nrm((NS, D, 2 * SG_HALF), D ** -0.5),
        "sg_ln_g": 1.0 + nrm((NS, SG_HALF), 0.02),
        "sg_ln_b": nrm((NS, SG_HALF), 0.02),
        "sg_w_s": nrm((NS, SG_GROUPS, SG_CHUNK, SG_CHUNK), SG_CHUNK ** -0.5),
        "sg_b_s": nrm((NS, SG_GROUPS, SG_CHUNK), 0.02),
        "sg_w_out": nrm((NS, SG_HALF, D), SG_HALF ** -0.5),
        "moe_w_router": nrm((DEPTH, D, E), D ** -0.5),
        "moe_router_bias": nrm((DEPTH, E), 0.01),
        "moe_w_gate": nrm((DEPTH, E, D, F), D ** -0.5),
        "moe_w_up": nrm((DEPTH, E, D, F), D ** -0.5),
        "moe_w_down": nrm((DEPTH, E, F, D), F ** -0.5),
        "moe_ws_gate": nrm((DEPTH, D, SHARED_DIM), D ** -0.5),
        "moe_ws_up": nrm((DEPTH, D, SHARED_DIM), D ** -0.5),
        "moe_ws_down": nrm((DEPTH, SHARED_DIM, D), SHARED_DIM ** -0.5),
        "final_g": 1.0 + nrm((D,), 0.02),
    }


def reference(x, c, positions, norm1_g, norm2_g, ada_w, ada_b,
              da_w_in, da_lam_q1, da_lam_k1, da_lam_q2, da_lam_k2, da_subln_g, da_w_out,
              sg_w_in, sg_ln_g, sg_ln_b, sg_w_s, sg_b_s, sg_w_out,
              moe_w_router, moe_router_bias, moe_w_gate, moe_w_up, moe_w_down,
              moe_ws_gate, moe_ws_up, moe_ws_down, final_g):
    cond = jax.nn.silu(c)
    for i in range(DEPTH):
        mod = cond @ ada_w[i] + ada_b[i]
        sh1, sc1, g1, sh2, sc2, g2 = jnp.split(mod, 6, axis=-1)
        h = modulate(rms_norm(x, norm1_g[i]), sh1, sc1)
        j = i // N_MIXERS
        if i % N_MIXERS == 0:
            lambda_init = 0.8 - 0.6 * math.exp(-0.3 * i)
            mix = diff_attention(h, positions, da_w_in[j], da_lam_q1[j], da_lam_k1[j],
                                 da_lam_q2[j], da_lam_k2[j], da_subln_g[j], da_w_out[j],
                                 lambda_init)
        else:
            mix = chunked_spatial_gating(h, sg_w_in[j], sg_ln_g[j], sg_ln_b[j],
                                         sg_w_s[j], sg_b_s[j], sg_w_out[j])
        x = x + g1[:, None, :] * mix
        h = modulate(rms_norm(x, norm2_g[i]), sh2, sc2)
        x = x + g2[:, None, :] * moe(h, moe_w_router[i], moe_router_bias[i], moe_w_gate[i],
                                     moe_w_up[i], moe_w_down[i], moe_ws_gate[i],
                                     moe_ws_up[i], moe_ws_down[i])
    return rms_norm(x, final_g)
```

```cpp
#include <hip/hip_runtime.h>
#include <cstdio>
#include <cstdint>

constexpr int BATCH = 8, SEQ = 8192, T = BATCH * SEQ, D = 1024;
constexpr int NE = 64, TOPK = 6;
constexpr int TK = T * TOPK;
constexpr int MAXRT = 1600;
constexpr float EPS = 1e-6f;
constexpr int NWAVES = 8;
#define REP_PRO 1
#define REP_NORM1 1
#define REP_QKV 1
#define REP_ATT 1
#define REP_DIFF 1
#define REP_SGIN 1
#define REP_SPAT 1
#define REP_DISP 1
#define REP_GU 1
#define REP_DOWN 1
#ifndef PHMASK
#define PHMASK 0xFFFF
#endif

__device__ __forceinline__ int opq(int x) { asm volatile("" : "+v"(x)); return x; }

namespace pg8 {
#define PG8_LAS __attribute__((address_space(3)))
typedef unsigned short bf16_t;
typedef short bf16x8 __attribute__((ext_vector_type(8)));
typedef float f32x4 __attribute__((ext_vector_type(4)));
typedef float f32x2 __attribute__((ext_vector_type(2)));
typedef unsigned u32x4 __attribute__((ext_vector_type(4)));
constexpr int BM = 256, BK = 64, HALF = 128, HTB = HALF * BK * 2, STAGE_BYTES = 8 * HTB, NXCD = 8, WGM = 8;

__host__ __device__ __forceinline__ int lds_byte(int r, int c) { const int st = (r >> 4) * 2 + (c >> 5), rr = r & 15, cc = c & 31, ob = rr * 64 + cc * 2; return st * 1024 + (ob ^ (((ob >> 9) & 1) << 5)); }
__host__ __device__ __forceinline__ void stage_rc(int b, int& R, int& C) { const int st = b / 1024, sb = b % 1024, swz = sb ^ (((sb >> 9) & 1) << 5); R = (st >> 1) * 16 + swz / 64; C = (st & 1) * 32 + (swz % 64) / 2; }
__host__ __device__ __forceinline__ int perm32(int rho) { const int n = rho >> 4, i = rho & 15; return 8 * (i >> 2) + 4 * n + (i & 3); }

struct Unit { int pm, pn; };

__device__ __forceinline__ unsigned cvt_pk_bf16(float lo, float hi) { unsigned r; asm volatile("v_cvt_pk_bf16_f32 %0, %1, %2" : "=v"(r) : "v"(lo), "v"(hi)); return r; }
__device__ __forceinline__ f32x2 gelu_pk(f32x2 v) {
    const f32x2 av = __builtin_elementwise_abs(v), d = av * 0.2316418882f + 1.0f;
    f32x2 t; t.x = __builtin_amdgcn_rcpf(d.x); t.y = __builtin_amdgcn_rcpf(d.y);
    f32x2 q = t * 0.5307027145f + (-0.7265760135f); q = q * t + 0.7107068705f; q = q * t + (-0.142248368f); q = q * t + 0.127414796f; q = q * t;
    const f32x2 s = (v * v) * (-0.72134752044f);
    f32x2 e; e.x = __builtin_amdgcn_exp2f(s.x); e.y = __builtin_amdgcn_exp2f(s.y);
    const f32x2 m = v * (q * e), r = v - m;
    f32x2 o; o.x = v.x < 0.f ? m.x : r.x; o.y = v.y < 0.f ? m.y : r.y; return o;
}

struct ProbDense {
    static constexpr bool GATHER = false;
    int nM, nN, nwg, G, c; const bf16_t* Bt; int K;
    __device__ __forceinline__ void init(int M, int N, int K_, const bf16_t* Bt_, int G_, int c_) { nM = M / BM; nN = N / BM; nwg = nM * nN; G = G_; c = c_; Bt = Bt_; K = K_; }
    __device__ __forceinline__ bool next(int i, Unit& u) const {
        const long L = (long)i * G + c; if (L >= nwg) return false;
        int wgid = (int)L; { const int q = nwg / NXCD, r = nwg % NXCD, xcd = wgid % NXCD, off = wgid / NXCD; wgid = (xcd < r ? xcd * (q + 1) : r * (q + 1) + (xcd - r) * q) + off; }
        const int nig = WGM * nN, gid = wgid / nig, fm = gid * WGM, gsz = (nM - fm) < WGM ? (nM - fm) : WGM;
        u.pm = fm + ((wgid % nig) % gsz); u.pn = (wgid % nig) / gsz; return true;
    }
    __device__ __forceinline__ const char* bbase(const Unit& u) const { return (const char*)Bt + (size_t)u.pn * BM * K * 2; }
    __device__ __forceinline__ size_t abase(const Unit& u) const { return (size_t)u.pm * BM * K * 2; }
    __device__ __forceinline__ unsigned arow(const Unit& u, int r) const { return (unsigned)(u.pm * BM + r); }
};

template <int ACT> struct EpiBf16 {
    static constexpr bool PERM = true; static constexpr bool PERM16 = false;
    bf16_t* O; int ldc;
    __device__ __forceinline__ void operator()(const f32x4 (&acc)[2][2][4][2], const Unit& u, int wr, int wc, int fr, int fq) const {
        const int row0 = u.pm * BM + wr * 64 + fr, col0 = u.pn * BM + wc * 32 + 8 * fq;
#pragma unroll
        for (int ai = 0; ai < 2; ++ai)
#pragma unroll
            for (int m = 0; m < 4; ++m) { bf16_t* rowp = O + (size_t)(row0 + ai * HALF + m * 16) * ldc + col0;
#pragma unroll
                for (int bj = 0; bj < 2; ++bj) { f32x4 v0 = acc[ai][bj][m][0], v1 = acc[ai][bj][m][1];
                    if (ACT == 1) { f32x2 a = gelu_pk((f32x2){v0[0], v0[1]}), b = gelu_pk((f32x2){v0[2], v0[3]}), c = gelu_pk((f32x2){v1[0], v1[1]}), d = gelu_pk((f32x2){v1[2], v1[3]});
                        v0 = (f32x4){a.x, a.y, b.x, b.y}; v1 = (f32x4){c.x, c.y, d.x, d.y}; }
                    u32x4 w; w.x = cvt_pk_bf16(v0[0], v0[1]); w.y = cvt_pk_bf16(v0[2], v0[3]); w.z = cvt_pk_bf16(v1[0], v1[1]); w.w = cvt_pk_bf16(v1[2], v1[3]);
                    *(u32x4*)(rowp + bj * HALF) = w; } }
    }
};
struct EpiQKV {
    static constexpr bool PERM = true; static constexpr bool PERM16 = false;
    bf16_t* Q; size_t sec_stride; const float* cosT; const float* sinT; float qscale;
    __device__ __forceinline__ void operator()(const f32x4 (&acc)[2][2][4][2], const Unit& u, int wr, int wc, int fr, int fq) const {
        const int colt = u.pn * BM, sec = colt >> 10, cin = colt & 1023;
        bf16_t* base = Q + (size_t)sec * sec_stride;
        const int row0 = u.pm * BM + wr * 64 + fr, col0 = cin + wc * 32 + 8 * fq, g = 4 * (wc & 1) + fq;
        const float qs = sec == 0 ? qscale : 1.0f;
#pragma unroll
        for (int ai = 0; ai < 2; ++ai)
#pragma unroll
            for (int m = 0; m < 4; ++m) { const int row = row0 + ai * HALF + m * 16; bf16_t* rowp = base + (size_t)row * 1024 + col0;
                f32x4 c4 = (f32x4){1.f, 1.f, 1.f, 1.f}, s4 = (f32x4){0.f, 0.f, 0.f, 0.f};
                if (sec < 2) { c4 = *(const f32x4*)(cosT + (size_t)row * 32 + 4 * g); s4 = *(const f32x4*)(sinT + (size_t)row * 32 + 4 * g); }
#pragma unroll
                for (int bj = 0; bj < 2; ++bj) { const f32x4 x1 = acc[ai][bj][m][0], x2 = acc[ai][bj][m][1];
                    const f32x4 v0 = (x1 * c4 - x2 * s4) * qs, v1 = (x2 * c4 + x1 * s4) * qs;
                    u32x4 w; w.x = cvt_pk_bf16(v0[0], v0[1]); w.y = cvt_pk_bf16(v0[2], v0[3]); w.z = cvt_pk_bf16(v1[0], v1[1]); w.w = cvt_pk_bf16(v1[2], v1[3]);
                    *(u32x4*)(rowp + bj * HALF) = w; } }
    }
};
template <bool BASE_F32> struct EpiRes {
    static constexpr bool PERM = true; static constexpr bool PERM16 = false;
    const void* base; bf16_t* out; const float* gate;
    __device__ __forceinline__ void operator()(const f32x4 (&acc)[2][2][4][2], const Unit& u, int wr, int wc, int fr, int fq) const {
        const int b = (u.pm * BM) / SEQ; const float* gp = gate + (size_t)b * 6144;
        const int col0 = u.pn * BM + wc * 32 + 8 * fq;
        f32x4 gv[2][2];
#pragma unroll
        for (int bj = 0; bj < 2; ++bj)
#pragma unroll
            for (int n = 0; n < 2; ++n) gv[bj][n] = *(const f32x4*)(gp + col0 + bj * HALF + n * 4);
#pragma unroll
        for (int ai = 0; ai < 2; ++ai)
#pragma unroll
            for (int m = 0; m < 4; ++m) { const size_t off = (size_t)(u.pm * BM + ai * HALF + wr * 64 + m * 16 + fr) * 1024 + col0;
#pragma unroll
                for (int bj = 0; bj < 2; ++bj) { f32x4 b0, b1;
                    if constexpr (BASE_F32) { b0 = *(const f32x4*)((const float*)base + off + bj * HALF); b1 = *(const f32x4*)((const float*)base + off + bj * HALF + 4); }
                    else { const u32x4 w = *(const u32x4*)((const bf16_t*)base + off + bj * HALF);
                        b0 = (f32x4){__uint_as_float(w.x << 16), __uint_as_float(w.x & 0xffff0000u), __uint_as_float(w.y << 16), __uint_as_float(w.y & 0xffff0000u)};
                        b1 = (f32x4){__uint_as_float(w.z << 16), __uint_as_float(w.z & 0xffff0000u), __uint_as_float(w.w << 16), __uint_as_float(w.w & 0xffff0000u)}; }
                    const f32x4 o0 = b0 + gv[bj][0] * acc[ai][bj][m][0], o1 = b1 + gv[bj][1] * acc[ai][bj][m][1];
                    u32x4 ow; ow.x = cvt_pk_bf16(o0[0], o0[1]); ow.y = cvt_pk_bf16(o0[2], o0[3]); ow.z = cvt_pk_bf16(o1[0], o1[1]); ow.w = cvt_pk_bf16(o1[2], o1[3]);
                    *(u32x4*)(out + off + bj * HALF) = ow; } }
    }
};
struct EpiGU {
    static constexpr bool PERM = true; static constexpr bool PERM16 = false;
    bf16_t* H; const float* wslot;
    __device__ __forceinline__ void operator()(const f32x4 (&acc)[2][2][4][2], const Unit& u, int wr, int wc, int fr, int fq) const {
        const int row0 = u.pm * BM + wr * 64 + fr, col0 = u.pn * 128 + wc * 32 + 8 * fq;
        float wv[2][4];
#pragma unroll
        for (int ai = 0; ai < 2; ++ai)
#pragma unroll
            for (int m = 0; m < 4; ++m) wv[ai][m] = wslot[row0 + ai * HALF + m * 16];
#pragma unroll
        for (int ai = 0; ai < 2; ++ai)
#pragma unroll
            for (int m = 0; m < 4; ++m) { bf16_t* rowp = H + (size_t)(row0 + ai * HALF + m * 16) * 256 + col0;
                float h[8];
#pragma unroll
                for (int n = 0; n < 2; ++n)
#pragma unroll
                    for (int j = 0; j < 4; ++j) { const float gt = acc[ai][0][m][n][j], up = acc[ai][1][m][n][j];
                        h[n * 4 + j] = gt * __builtin_amdgcn_rcpf(1.0f + __builtin_amdgcn_exp2f(-1.4426950408889634f * gt)) * (up * wv[ai][m]); }
                u32x4 w; w.x = cvt_pk_bf16(h[0], h[1]); w.y = cvt_pk_bf16(h[2], h[3]); w.z = cvt_pk_bf16(h[4], h[5]); w.w = cvt_pk_bf16(h[6], h[7]);
                *(u32x4*)rowp = w; }
    }
};
struct EpiDown {
    static constexpr bool PERM = true; static constexpr bool PERM16 = true;
    unsigned char* Y;
    __device__ __forceinline__ void operator()(const f32x4 (&acc)[2][2][4][2], const Unit& u, int wr, int wc, int fr, int fq) const {
        const int row0 = u.pm * BM + wr * 64 + fr, col0 = u.pn * BM + wc * 64 + 16 * fq;
#pragma unroll
        for (int ai = 0; ai < 2; ++ai)
#pragma unroll
            for (int m = 0; m < 4; ++m) { unsigned char* rowp = Y + (size_t)(row0 + ai * HALF + m * 16) * 1024 + col0;
                u32x4 w;
#pragma unroll
                for (int bj = 0; bj < 2; ++bj)
#pragma unroll
                    for (int n = 0; n < 2; ++n) { f32x4 v = acc[ai][bj][m][n] * 16.0f;
#pragma unroll
                        for (int j = 0; j < 4; ++j) v[j] = __builtin_fminf(__builtin_fmaxf(v[j], -440.f), 440.f);
                        int q = __builtin_amdgcn_cvt_pk_fp8_f32(v[0], v[1], 0, false); q = __builtin_amdgcn_cvt_pk_fp8_f32(v[2], v[3], q, true);
                        w[2 * bj + n] = (unsigned)q; }
                *(u32x4*)rowp = w; }
    }
};

template <class Epi, class Prob, bool ALIGN_EPI>
__device__ __forceinline__ void gemm_phase(PG8_LAS unsigned char* lds, const bf16_t* Aglob, const int K, const Prob& S, const Epi& E) {
    const int tid = opq(threadIdx.x), wid = __builtin_amdgcn_readfirstlane(tid >> 6), lane = tid & 63, wr = wid >> 2, wc = wid & 3, fr = lane & 15, fq = lane >> 4;
    const int nt = K / BK;
    int Rr[2]; unsigned cA2[2], voffA[2], voffB[2];
#pragma unroll
    for (int i = 0; i < 2; ++i) { int R, C; stage_rc(tid * 16 + i * 8192, R, C); const int Rb = Epi::PERM16 ? (64 * (R >> 5) + 16 * ((R & 15) >> 2) + 4 * ((R >> 4) & 1) + (R & 3)) : (Epi::PERM ? ((R & ~31) + perm32(R & 31)) : R);
        Rr[i] = R; cA2[i] = (unsigned)C * 2u; voffA[i] = (unsigned)(R * K + C) * 2u; voffB[i] = (unsigned)(Rb * K + C) * 2u; }
    const unsigned rowbytes = (unsigned)K * 2u;
    const size_t kstep = (size_t)(BK * 2);
    const size_t hstep = (size_t)HALF * K * 2;
    const size_t hstepB = Epi::PERM16 ? (size_t)8 * K * 2 : hstep;
    const unsigned ldsw = (unsigned)wid * 1024u;
    const int aoff = lds_byte(wr * 64 + fr, fq * 8), boff = lds_byte(wc * 32 + fr, fq * 8);
#define PG8_SA(b, h) (((b) * 2 + (h)) * HTB)
#define PG8_SB(b, h) ((4 + (b) * 2 + (h)) * HTB)
#define PG8_STAGE(bufoff, gbase, voff) do { _Pragma("unroll") for (int _i = 0; _i < 2; ++_i) \
        __builtin_amdgcn_global_load_lds((const unsigned*)((const char*)(gbase) + (voff)[_i]), (PG8_LAS unsigned*)(lds + (bufoff) + ldsw + _i * 8192), 16, 0, 0); } while (0)
#define PG8_STAGE_A(bufoff, koff, h, NXT) do { if constexpr (Prob::GATHER) { PG8_STAGE(bufoff, Ab + (koff), (NXT) ? v2[h] : vAc[h]); } \
        else { PG8_STAGE(bufoff, ((NXT) ? a2u : cA) + (koff) + (h) * hstep, voffA); } } while (0)
#define PG8_LDA(dst, b, h) do { _Pragma("unroll") for (int m = 0; m < 4; ++m) _Pragma("unroll") for (int k = 0; k < 2; ++k) dst[m][k] = *(const PG8_LAS bf16x8*)(lds + PG8_SA(b, h) + aoff + m * 2048 + k * 1024); } while (0)
#define PG8_LDB(dst, b, h) do { _Pragma("unroll") for (int n = 0; n < 2; ++n) _Pragma("unroll") for (int k = 0; k < 2; ++k) dst[n][k] = *(const PG8_LAS bf16x8*)(lds + PG8_SB(b, h) + boff + n * 2048 + k * 1024); } while (0)
#define PG8_MMA(ai, bj, At, Bt) do { __builtin_amdgcn_s_setprio(1); _Pragma("unroll") for (int m = 0; m < 4; ++m) _Pragma("unroll") for (int n = 0; n < 2; ++n) _Pragma("unroll") for (int k = 0; k < 2; ++k) \
        acc[ai][bj][m][n] = __builtin_amdgcn_mfma_f32_16x16x32_bf16(Bt[n][k], At[m][k], acc[ai][bj][m][n], 0, 0, 0); __builtin_amdgcn_s_setprio(0); } while (0)
#define PG8_WAIT_V(n) asm volatile("s_waitcnt vmcnt(" #n ")" ::: "memory")
#define PG8_WAIT_L(n) asm volatile("s_waitcnt lgkmcnt(" #n ")" ::: "memory")
#define PG8_BAR __builtin_amdgcn_s_barrier()
#define PG8_SCHED __builtin_amdgcn_sched_barrier(0)
    Unit cur, nxt; int ui = 0;
    if (!S.next(0, cur)) return;
    f32x4 acc[2][2][4][2];
#pragma unroll
    for (int a = 0; a < 2; ++a)
#pragma unroll
        for (int b = 0; b < 2; ++b)
#pragma unroll
            for (int m = 0; m < 4; ++m)
#pragma unroll
                for (int n = 0; n < 2; ++n) acc[a][b][m][n] = (f32x4){0.f, 0.f, 0.f, 0.f};
    bf16x8 At[4][2], B0[2][2], B1[2][2];
    unsigned vAc[2][2], vAn[2][2], v2[2][2];
    const char* Ab = (const char*)Aglob; const char* cB = S.bbase(cur);
    const char* cA = Ab; const char* a2u = Ab;
    if constexpr (Prob::GATHER) {
#pragma unroll
        for (int h = 0; h < 2; ++h)
#pragma unroll
            for (int i = 0; i < 2; ++i) { vAc[h][i] = S.arow(cur, h * HALF + Rr[i]) * rowbytes + cA2[i]; v2[h][i] = vAc[h][i]; vAn[h][i] = vAc[h][i]; }
    } else { cA = Ab + S.abase(cur); a2u = cA; }
    PG8_STAGE(PG8_SB(0, 0), cB, voffB); PG8_STAGE(PG8_SB(0, 1), cB + hstepB, voffB); PG8_STAGE_A(PG8_SA(0, 0), 0, 0, false); PG8_STAGE_A(PG8_SA(0, 1), 0, 1, false);
    if (wr == 1) PG8_BAR;
    PG8_WAIT_V(2); PG8_BAR;
    PG8_STAGE(PG8_SB(1, 0), cB + kstep, voffB); PG8_STAGE_A(PG8_SA(1, 0), kstep, 0, false); PG8_STAGE(PG8_SB(1, 1), cB + hstepB + kstep, voffB);
    PG8_WAIT_V(6); PG8_BAR;
#pragma unroll 1
    for (;;) {
        const bool has_next = S.next(ui + 1, nxt);
        const Unit nn = has_next ? nxt : cur;
        const char* nB = S.bbase(nn);
        const char* nA = Ab;
        if constexpr (Prob::GATHER) {
#pragma unroll
            for (int h = 0; h < 2; ++h)
#pragma unroll
                for (int i = 0; i < 2; ++i) vAn[h][i] = S.arow(nn, h * HALF + Rr[i]);
        } else nA = Ab + S.abase(nn);
#pragma unroll 1
        for (int t = 0; t < nt; t += 2) {
            const bool last = (t == nt - 2);
            const size_t k1 = (size_t)(t + 1) * kstep;
            const size_t k2 = last ? 0 : (size_t)(t + 2) * kstep, k3 = k2 + kstep;
            const char* b2 = last ? nB : cB + (size_t)(t + 2) * kstep; const char* b3 = b2 + kstep;
            if constexpr (Prob::GATHER) {
                if (last) {
#pragma unroll
                    for (int h = 0; h < 2; ++h)
#pragma unroll
                        for (int i = 0; i < 2; ++i) { asm volatile("" : "+v"(vAn[h][i])); vAn[h][i] = vAn[h][i] * rowbytes + cA2[i]; }
                }
#pragma unroll
                for (int h = 0; h < 2; ++h)
#pragma unroll
                    for (int i = 0; i < 2; ++i) v2[h][i] = last ? vAn[h][i] : vAc[h][i];
            } else a2u = last ? nA : cA;
            PG8_LDB(B0, 0, 0); PG8_LDB(B1, 0, 1); PG8_SCHED; PG8_LDA(At, 0, 0); PG8_STAGE_A(PG8_SA(1, 1), k1, 1, false);
            PG8_WAIT_V(8); PG8_WAIT_L(0); PG8_BAR; PG8_MMA(0, 0, At, B0); PG8_MMA(0, 1, At, B1); PG8_BAR; PG8_SCHED;
            PG8_LDA(At, 0, 1); PG8_STAGE(PG8_SB(0, 0), b2, voffB); PG8_STAGE(PG8_SB(0, 1), b2 + hstepB, voffB); PG8_STAGE_A(PG8_SA(0, 0), k2, 0, true);
            PG8_WAIT_V(8); PG8_WAIT_L(0); PG8_BAR; PG8_MMA(1, 0, At, B0); PG8_MMA(1, 1, At, B1); PG8_BAR; PG8_SCHED;
            PG8_LDB(B0, 1, 0); PG8_LDB(B1, 1, 1); PG8_SCHED; PG8_LDA(At, 1, 0); PG8_STAGE_A(PG8_SA(0, 1), k2, 1, true);
            PG8_WAIT_V(8); PG8_WAIT_L(0); PG8_BAR; PG8_MMA(0, 0, At, B0); PG8_MMA(0, 1, At, B1); PG8_BAR; PG8_SCHED;
            PG8_LDA(At, 1, 1); PG8_STAGE(PG8_SB(1, 0), b3, voffB); PG8_STAGE(PG8_SB(1, 1), b3 + hstepB, voffB); PG8_STAGE_A(PG8_SA(1, 0), k3, 0, true);
            PG8_WAIT_V(8); PG8_WAIT_L(0); PG8_BAR; PG8_MMA(1, 0, At, B0); PG8_MMA(1, 1, At, B1); PG8_BAR; PG8_SCHED;
        }
        if constexpr (ALIGN_EPI) { if (wr == 0) PG8_BAR; }
        E(acc, cur, wr, wc, fr, fq);
        if (!has_next) break;
#pragma unroll
        for (int a = 0; a < 2; ++a)
#pragma unroll
            for (int b = 0; b < 2; ++b)
#pragma unroll
                for (int m = 0; m < 4; ++m)
#pragma unroll
                    for (int n = 0; n < 2; ++n) acc[a][b][m][n] = (f32x4){0.f, 0.f, 0.f, 0.f};
        cur = nxt; cB = nB; cA = nA; ++ui;
        if constexpr (Prob::GATHER) {
#pragma unroll
            for (int h = 0; h < 2; ++h)
#pragma unroll
                for (int i = 0; i < 2; ++i) vAc[h][i] = vAn[h][i];
        }
        if constexpr (ALIGN_EPI) { if (wr == 1) PG8_BAR; }
    }
    PG8_WAIT_V(0);
    if constexpr (!ALIGN_EPI) { if (wr == 0) PG8_BAR; }
    PG8_BAR;
#undef PG8_SA
#undef PG8_SB
#undef PG8_STAGE
#undef PG8_STAGE_A
#undef PG8_LDA
#undef PG8_LDB
#undef PG8_MMA
#undef PG8_WAIT_V
#undef PG8_WAIT_L
#undef PG8_BAR
#undef PG8_SCHED
}
}

namespace att {
typedef unsigned short bf16_t;
using bf16x8 = __attribute__((ext_vector_type(8))) short;
using s16x4  = __attribute__((ext_vector_type(4))) short;
using f32x16 = __attribute__((ext_vector_type(16))) float;
using u32x4  = __attribute__((ext_vector_type(4))) unsigned;
constexpr int NW = 8, QBLK = 32, KVBLK = 64;
constexpr float QSCALE = 0.125f * 1.4426950408889634f;
constexpr float THRL = 11.5f;
constexpr int LDQ = 1024, LDK = 1024, LDV = 1024, LDO = 2048;
constexpr size_t SHM_V = KVBLK * 128 * 2, SHM_K = KVBLK * 64 * 2, SHM_ATTN = 3 * SHM_V + 3 * SHM_K;
#define KSWZ(row, colB) ((row) * 128 + ((colB) ^ ((((row) >> 1) & 7) << 4)))
#define SBAR() __builtin_amdgcn_sched_barrier(0)
__device__ __forceinline__ int crow(int r, int hi) { return (r & 3) + 8 * (r >> 2) + 4 * hi; }
__device__ __forceinline__ unsigned cvtpk(float lo, float hi) { unsigned r; asm volatile("v_cvt_pk_bf16_f32 %0, %1, %2" : "=v"(r) : "v"(lo), "v"(hi)); return r; }

template <bool FIRST> __device__ __forceinline__ void partialSM(f32x16& p0, f32x16& p1, float& mhat, f32x16& negm, float& alpha) {
  float ma = fmaxf(p0[0], p0[1]), mb = fmaxf(p0[2], p0[3]), mc = fmaxf(p1[0], p1[1]), md = fmaxf(p1[2], p1[3]);
#pragma unroll
  for (int r = 4; r < 16; r += 4) { ma = fmaxf(fmaxf(ma, p0[r]), p0[r + 1]); mb = fmaxf(fmaxf(mb, p0[r + 2]), p0[r + 3]); mc = fmaxf(fmaxf(mc, p1[r]), p1[r + 1]); md = fmaxf(fmaxf(md, p1[r + 2]), p1[r + 3]); }
  const float pmaxh = fmaxf(fmaxf(ma, mb), fmaxf(mc, md));
  alpha = 1.f;
  if (FIRST || !__builtin_expect(__all(pmaxh <= THRL), 1)) {
    float pmax; { auto rr = __builtin_amdgcn_permlane32_swap(__float_as_uint(pmaxh), __float_as_uint(pmaxh), false, false);
      pmax = fmaxf(__uint_as_float(rr[0]), __uint_as_float(rr[1])); }
    const float dl = FIRST ? pmax : fmaxf(pmax, 0.f);
    mhat += dl; if (!FIRST) alpha = __builtin_amdgcn_exp2f(-dl);
#pragma unroll
    for (int r = 0; r < 16; ++r) { p0[r] -= dl; p1[r] -= dl; }
#pragma unroll
    for (int r = 0; r < 16; ++r) negm[r] = -mhat;
    asm volatile("" : "+v"(negm));
  }
#pragma unroll
  for (int r = 0; r < 16; ++r) p0[r] = __builtin_amdgcn_exp2f(p0[r]);
}
__device__ __forceinline__ void finishSM(f32x16& p0, f32x16& p1, float alpha, float& l_reg, bf16x8& pb0, bf16x8& pb1, bf16x8& pb2, bf16x8& pb3) {
#pragma unroll
  for (int r = 0; r < 16; ++r) p1[r] = __builtin_amdgcn_exp2f(p1[r]);
  float ps = 0;
#pragma unroll
  for (int r = 0; r < 16; ++r) ps += p0[r];
#pragma unroll
  for (int r = 0; r < 16; ++r) ps += p1[r];
  { auto rr = __builtin_amdgcn_permlane32_swap(__float_as_uint(ps), __float_as_uint(ps), false, false);
    ps = __uint_as_float(rr[0]) + __uint_as_float(rr[1]); }
  l_reg = l_reg * alpha + ps;
#define PK8(P, BASE, OUT) do { u32x4 w = {cvtpk(P[BASE + 0], P[BASE + 1]), cvtpk(P[BASE + 2], P[BASE + 3]), cvtpk(P[BASE + 4], P[BASE + 5]), cvtpk(P[BASE + 6], P[BASE + 7])}; OUT = *reinterpret_cast<bf16x8*>(&w); } while (0)
  PK8(p0, 0, pb0); PK8(p0, 8, pb1); PK8(p1, 0, pb2); PK8(p1, 8, pb3);
#undef PK8
}
__device__ __forceinline__ void qkt(f32x16& p0, f32x16& p1, const char* Ks, const bf16x8* qr, const f32x16& negm, int r32, int hi) {
#pragma unroll
  for (int d0 = 0; d0 < 4; ++d0) { const int cb = (d0 * 16 + hi * 8) * 2;
    bf16x8 b0 = *reinterpret_cast<const bf16x8*>(Ks + KSWZ(r32, cb));
    bf16x8 b1 = *reinterpret_cast<const bf16x8*>(Ks + KSWZ(32 + r32, cb));
    if (d0 == 0) { p0 = __builtin_amdgcn_mfma_f32_32x32x16_bf16(b0, qr[0], negm, 0, 0, 0); p1 = __builtin_amdgcn_mfma_f32_32x32x16_bf16(b1, qr[0], negm, 0, 0, 0); }
    else { p0 = __builtin_amdgcn_mfma_f32_32x32x16_bf16(b0, qr[d0], p0, 0, 0, 0); p1 = __builtin_amdgcn_mfma_f32_32x32x16_bf16(b1, qr[d0], p1, 0, 0, 0); } }
}
__device__ __forceinline__ int v_st(int k, int c) { const int kk = (k & ~0xC) | ((k & 4) << 1) | ((k & 8) >> 1); return ((kk >> 3) * 4 + (c >> 5)) * 512 + ((kk & 7) * 32 + (c & 31)) * 2; }
__device__ __forceinline__ int v_st_n(int k, int c) { return ((k >> 3) * 4 + (c >> 5)) * 512 + ((k & 7) * 32 + (c & 31)) * 2; }
__device__ __forceinline__ int v_rd_base(int lane) { return ((lane & 3) << 3) | (((lane >> 2) & 3) << 6) | (((lane >> 4) & 1) << 5) | (((lane >> 5) & 1) << 8); }
constexpr int v_rd_off(int d0, int ks, int half) { return d0 * 512 + ks * 4096 + half * 2048; }
template <int OFF> __device__ __forceinline__ s16x4 tr_read(int vb) {
  s16x4 r; asm volatile("ds_read_b64_tr_b16 %0, %1 offset:%2" : "=&v"(r) : "v"(vb), "i"(OFF) : "memory"); return r;
}
template <int D0> __device__ __forceinline__ void pv_one(f32x16& od, int vb, bf16x8 pa0, bf16x8 pa1, bf16x8 pa2, bf16x8 pa3) {
  const s16x4 l0 = tr_read<v_rd_off(D0, 0, 0)>(vb), h0 = tr_read<v_rd_off(D0, 0, 1)>(vb), l1 = tr_read<v_rd_off(D0, 1, 0)>(vb), h1 = tr_read<v_rd_off(D0, 1, 1)>(vb);
  const s16x4 l2 = tr_read<v_rd_off(D0, 2, 0)>(vb), h2 = tr_read<v_rd_off(D0, 2, 1)>(vb), l3 = tr_read<v_rd_off(D0, 3, 0)>(vb), h3 = tr_read<v_rd_off(D0, 3, 1)>(vb);
  asm volatile("s_waitcnt lgkmcnt(0)" ::: "memory"); SBAR();
#define PK(L, H) (bf16x8){L[0], L[1], L[2], L[3], H[0], H[1], H[2], H[3]}
  od = __builtin_amdgcn_mfma_f32_32x32x16_bf16(pa0, PK(l0, h0), od, 0, 0, 0);
  od = __builtin_amdgcn_mfma_f32_32x32x16_bf16(pa1, PK(l1, h1), od, 0, 0, 0);
  od = __builtin_amdgcn_mfma_f32_32x32x16_bf16(pa2, PK(l2, h2), od, 0, 0, 0);
  od = __builtin_amdgcn_mfma_f32_32x32x16_bf16(pa3, PK(l3, h3), od, 0, 0, 0);
#undef PK
}
__device__ __forceinline__ void pv_d0(f32x16* o, int vb, bf16x8 pa0, bf16x8 pa1, bf16x8 pa2, bf16x8 pa3) {
  pv_one<0>(o[0], vb, pa0, pa1, pa2, pa3); pv_one<1>(o[1], vb, pa0, pa1, pa2, pa3); pv_one<2>(o[2], vb, pa0, pa1, pa2, pa3); pv_one<3>(o[3], vb, pa0, pa1, pa2, pa3);
}
template <int D0> __device__ __forceinline__ void pvT_one(f32x16& od, int vb, bf16x8 pb0, bf16x8 pb1, bf16x8 pb2, bf16x8 pb3) {
  const s16x4 l0 = tr_read<v_rd_off(D0, 0, 0)>(vb), h0 = tr_read<v_rd_off(D0, 0, 1)>(vb), l1 = tr_read<v_rd_off(D0, 1, 0)>(vb), h1 = tr_read<v_rd_off(D0, 1, 1)>(vb);
  const s16x4 l2 = tr_read<v_rd_off(D0, 2, 0)>(vb), h2 = tr_read<v_rd_off(D0, 2, 1)>(vb), l3 = tr_read<v_rd_off(D0, 3, 0)>(vb), h3 = tr_read<v_rd_off(D0, 3, 1)>(vb);
  asm volatile("s_waitcnt lgkmcnt(0)" ::: "memory"); SBAR();
#define PK(L, H) (bf16x8){L[0], L[1], L[2], L[3], H[0], H[1], H[2], H[3]}
  od = __builtin_amdgcn_mfma_f32_32x32x16_bf16(PK(l0, h0), pb0, od, 0, 0, 0);
  od = __builtin_amdgcn_mfma_f32_32x32x16_bf16(PK(l1, h1), pb1, od, 0, 0, 0);
  od = __builtin_amdgcn_mfma_f32_32x32x16_bf16(PK(l2, h2), pb2, od, 0, 0, 0);
  od = __builtin_amdgcn_mfma_f32_32x32x16_bf16(PK(l3, h3), pb3, od, 0, 0, 0);
#undef PK
}
__device__ __forceinline__ void pvT(f32x16* o, int vb, bf16x8 pb0, bf16x8 pb1, bf16x8 pb2, bf16x8 pb3) {
  pvT_one<0>(o[0], vb, pb0, pb1, pb2, pb3); pvT_one<1>(o[1], vb, pb0, pb1, pb2, pb3); pvT_one<2>(o[2], vb, pb0, pb1, pb2, pb3); pvT_one<3>(o[3], vb, pb0, pb1, pb2, pb3);
}
__device__ __forceinline__ unsigned short f2bf1(float f) { unsigned u = __builtin_bit_cast(unsigned, f); return (unsigned short)((u + 0x7fffu + ((u >> 16) & 1u)) >> 16); }

__device__ __forceinline__ void attn_core(const bf16_t* __restrict__ Qb, const bf16_t* __restrict__ Kh, const bf16_t* __restrict__ Vh, int seq, char* lds, f32x16 (&o)[4]) {
  const int tid = opq(threadIdx.x), wid = tid >> 6, lane = tid & 63, r32 = lane & 31, hi = lane >> 5;
  char* K_lds = lds; char* V_lds = lds + 3 * SHM_K;
  float mhat = 0.f, l_reg = 0; bf16x8 qr[4]; f32x16 negm = {}; asm volatile("" : "+v"(negm));
#pragma unroll
  for (int d = 0; d < 4; ++d) o[d] = f32x16{};
  const bf16_t* Qw = Qb + (long)(wid * QBLK + r32) * LDQ + hi * 8;
#pragma unroll
  for (int d0 = 0; d0 < 4; ++d0) qr[d0] = *reinterpret_cast<const bf16x8*>(Qw + d0 * 16);
  const int vb0 = (int)(uintptr_t)V_lds + v_rd_base(lane);
  const int wu = __builtin_amdgcn_readfirstlane(wid);
  const int krow = 8 * wu + (lane >> 3); const unsigned goK = (unsigned)(krow * LDK + (((lane & 7) ^ ((krow >> 1) & 7)) * 8)) * 2u;
  unsigned goV[2];
#pragma unroll
  for (int i2 = 0; i2 < 2; ++i2) { const int st = 2 * (2 * wu + i2) + (lane >> 5), w = lane & 31; goV[i2] = (unsigned)((((st >> 2) * 8 + (w >> 2)) * LDV) + (st & 3) * 32 + (w & 3) * 8) * 2u; }
  const unsigned kl0 = (unsigned)(uintptr_t)K_lds + (unsigned)wu * 1024u, vl0 = (unsigned)(uintptr_t)V_lds + (unsigned)wu * 2048u;
#define DMA16(voff, gbase, laddr) asm volatile("s_mov_b32 m0, %2\n\ts_nop 0\n\tglobal_load_lds_dwordx4 %0, %1" :: "v"(voff), "s"(gbase), "s"(laddr) : "memory", "m0")
#define SLOAD(slot, k0) do { const bf16_t* kt_ = Kh + (size_t)(k0) * LDK; const bf16_t* vt_ = Vh + (size_t)(k0) * LDV; \
    DMA16(goK, kt_, kl0 + (unsigned)(slot) * (unsigned)SHM_K); DMA16(goV[0], vt_, vl0 + (unsigned)(slot) * (unsigned)SHM_V); DMA16(goV[1], vt_, vl0 + (unsigned)(slot) * (unsigned)SHM_V + 1024u); } while (0)
#define SWAIT() asm volatile("s_waitcnt vmcnt(0)" ::: "memory")
#define RESC(a) do { if (__any((a) < 1.f)) { _Pragma("unroll") for (int d = 0; d < 4; ++d) _Pragma("unroll") for (int r = 0; r < 16; ++r) o[d][r] *= (a); } } while (0)
#define ROT() do { const int n_ = sm; sm = s0; s0 = s1; s1 = n_; } while (0)
  f32x16 pA0, pA1, pB0, pB1; float alA, alB; bf16x8 pa0, pa1, pa2, pa3; const int NT = seq / KVBLK;
  SLOAD(0, 0); SWAIT(); __syncthreads();
  SLOAD(1, KVBLK);
  qkt(pA0, pA1, K_lds, qr, negm, r32, hi); partialSM<true>(pA0, pA1, mhat, negm, alA);
  SWAIT(); __syncthreads();
  int sm = 2, s0 = 0, s1 = 1;
  for (int j = 1; j + 1 < NT; j += 2) {
    SBAR(); qkt(pB0, pB1, K_lds + s1 * (int)SHM_K, qr, negm, r32, hi);
    finishSM(pA0, pA1, alA, l_reg, pa0, pa1, pa2, pa3); SBAR();
    SLOAD(sm, (j + 1) * KVBLK); SBAR();
    pvT(o, vb0 + s0 * (int)SHM_V, pa0, pa1, pa2, pa3); partialSM<false>(pB0, pB1, mhat, negm, alB);
    RESC(alB); SWAIT(); __syncthreads(); ROT();
    SBAR(); qkt(pA0, pA1, K_lds + s1 * (int)SHM_K, qr, negm, r32, hi);
    finishSM(pB0, pB1, alB, l_reg, pa0, pa1, pa2, pa3); SBAR();
    SLOAD(sm, (j + 2) * KVBLK); SBAR();
    pvT(o, vb0 + s0 * (int)SHM_V, pa0, pa1, pa2, pa3); partialSM<false>(pA0, pA1, mhat, negm, alA);
    RESC(alA); SWAIT(); __syncthreads(); ROT();
  }
  SBAR(); qkt(pB0, pB1, K_lds + s1 * (int)SHM_K, qr, negm, r32, hi);
  finishSM(pA0, pA1, alA, l_reg, pa0, pa1, pa2, pa3); SBAR();
  pvT(o, vb0 + s0 * (int)SHM_V, pa0, pa1, pa2, pa3); partialSM<false>(pB0, pB1, mhat, negm, alB);
  RESC(alB);
  finishSM(pB0, pB1, alB, l_reg, pa0, pa1, pa2, pa3); SBAR();
  pvT(o, vb0 + s1 * (int)SHM_V, pa0, pa1, pa2, pa3);
#undef ROT
  { const float rl = __builtin_amdgcn_rcpf(l_reg);
#pragma unroll
    for (int d0 = 0; d0 < 4; ++d0)
#pragma unroll
      for (int r = 0; r < 16; ++r) o[d0][r] *= rl; }
  __syncthreads();
#undef SLOAD
#undef DMA16
#undef SWAIT
#undef RESC
}

constexpr size_t SHM_STASH = SHM_ATTN;
__device__ __forceinline__ void attn_pair_unit(const bf16_t* Qb, const bf16_t* Kh, const bf16_t* Vh, bf16_t* Ob, int seq, char* lds, float lam, const float* subg) {
  {
    f32x16 o[4];
    attn_core(Qb, Kh, Vh, seq, lds, o);
    const int tid = opq((int)threadIdx.x); unsigned* stash = (unsigned*)(lds + SHM_STASH) + (tid >> 6) * 2048 + (tid & 63);
#pragma unroll
    for (int r = 0; r < 16; ++r) { stash[(2 * r) * 64] = cvtpk(o[0][r], o[1][r]); stash[(2 * r + 1) * 64] = cvtpk(o[2][r], o[3][r]); }
  }
  {
    f32x16 o[4];
    attn_core(Qb + 64, Kh + 64, Vh, seq, lds, o);
    const int tid = opq((int)threadIdx.x), wid = tid >> 6, lane = tid & 63, r32 = lane & 31, hi = lane >> 5;
    const unsigned* stash = (const unsigned*)(lds + SHM_STASH) + wid * 2048 + lane;
    float ss = 0.f;
#pragma unroll
    for (int r = 0; r < 16; ++r) { const unsigned w0 = stash[(2 * r) * 64], w1 = stash[(2 * r + 1) * 64];
      o[0][r] = __uint_as_float(w0 << 16) - lam * o[0][r]; o[1][r] = __uint_as_float(w0 & 0xffff0000u) - lam * o[1][r];
      o[2][r] = __uint_as_float(w1 << 16) - lam * o[2][r]; o[3][r] = __uint_as_float(w1 & 0xffff0000u) - lam * o[3][r];
      ss += (o[0][r] * o[0][r] + o[1][r] * o[1][r]) + (o[2][r] * o[2][r] + o[3][r] * o[3][r]); }
    { auto rr = __builtin_amdgcn_permlane32_swap(__float_as_uint(ss), __float_as_uint(ss), false, false);
      ss = __uint_as_float(rr[0]) + __uint_as_float(rr[1]); }
    const float rs = 0.8f / sqrtf(ss * (1.0f / 128.0f) + 1e-6f);
    bf16_t* Ow = Ob + (long)(wid * QBLK + r32) * 1024 + 4 * hi;
    typedef unsigned u32x2 __attribute__((ext_vector_type(2))); typedef float f32x4_t __attribute__((ext_vector_type(4)));
#pragma unroll
    for (int d0 = 0; d0 < 4; ++d0)
#pragma unroll
      for (int rq = 0; rq < 4; ++rq) { const int dv = 32 * d0 + 8 * rq;
        const f32x4_t g = *(const f32x4_t*)(subg + dv + 4 * hi);
        u32x2 w; w.x = cvtpk(o[d0][4 * rq] * rs * g[0], o[d0][4 * rq + 1] * rs * g[1]); w.y = cvtpk(o[d0][4 * rq + 2] * rs * g[2], o[d0][4 * rq + 3] * rs * g[3]);
        *(u32x2*)(Ow + dv) = w; }
  }
}
}

constexpr size_t MiB = 1u << 20;
constexpr size_t WS_CTL = 0, CTL_ZERO_BYTES = 65536;
constexpr size_t WS_MOD = 1 * MiB;
constexpr size_t WS_COS = 2 * MiB, WS_SIN = 10 * MiB;
constexpr size_t WS_AE = 18 * MiB, WS_APOS = 20 * MiB, WS_AW = 22 * MiB;
constexpr size_t WS_TOK = 24 * MiB, WS_WSLOT = 26 * MiB, WS_SLOTOF = 28 * MiB, WS_TILEE = 30 * MiB;
constexpr size_t WS_WSB = 31 * MiB;
constexpr size_t WS_WRT = 31 * MiB + 512 * 1024;
constexpr size_t WS_WQKV = 32 * MiB, WS_WO = 38 * MiB, WS_WSGIN = 40 * MiB, WS_WSGOUT = 48 * MiB;
constexpr size_t WS_WGU = 56 * MiB;
constexpr size_t WS_WD = 121 * MiB;
constexpr size_t WS_WSD = 153 * MiB;
constexpr size_t WS_ACT = 156 * MiB;
constexpr size_t WS_A0 = WS_ACT;
constexpr size_t WS_Q = WS_ACT + 128 * MiB, WS_K = WS_ACT + 256 * MiB, WS_V = WS_ACT + 384 * MiB, WS_OS = WS_ACT + 512 * MiB;
constexpr size_t WS_HMOE = WS_ACT + 128 * MiB;
constexpr size_t WS_Y = WS_ACT + 368 * MiB;
constexpr size_t WS_Z = WS_ACT + 256 * MiB;
constexpr size_t WS_WRP = WS_ACT + 832 * MiB;
constexpr size_t WS_RC = WS_WRP + 4 * MiB;
constexpr size_t WS_END = WS_RC + 1 * MiB;
static_assert(WS_WGU + (size_t)65 * 512 * 1024 * 2 <= WS_WD && WS_WD + (size_t)64 * 1024 * 256 * 2 <= WS_WSD && WS_WSD + 1024 * 256 * 2 <= WS_ACT, "weights map");
static_assert(WS_K - WS_Q == WS_V - WS_K, "Q/K/V equally spaced");
static_assert(WS_HMOE + (size_t)(T + MAXRT * 256) * 256 * 2 <= WS_Y && WS_Y + (size_t)(T + MAXRT * 256) * 1024 <= WS_WRP && WS_Z + (size_t)T * 4096 * 2 <= WS_WRP && WS_WD + (size_t)64 * 1024 * 256 * 2 == WS_WSD, "moe map");
static_assert(WS_TOK + (size_t)(T + MAXRT * 256) * 4 <= WS_WSLOT && WS_WSLOT + (size_t)(T + MAXRT * 256) * 4 <= WS_SLOTOF && WS_SLOTOF + (size_t)TK * 4 <= WS_TILEE, "dispatch map");
constexpr int CW_BAR = 4096, CW_CNT = 8192;

constexpr size_t CV_OUT_OFF = (size_t)128 * MiB;
#ifndef CV_SPLIT
#define CV_SPLIT (65 * 384 * 7 / 10)
#endif
constexpr int RING_BYTES = 131072, LDSCTL_OFF = 143360, MISC_OFF = LDSCTL_OFF + 320, LDS_BYTES = 147456;

#define GAS __attribute__((address_space(1)))
#define LAS __attribute__((address_space(3)))
typedef unsigned short bf16;
typedef unsigned v4u __attribute__((ext_vector_type(4)));
typedef unsigned v2u __attribute__((ext_vector_type(2)));
typedef float f32x4 __attribute__((ext_vector_type(4)));
typedef float f32x16 __attribute__((ext_vector_type(16)));
typedef short bf16x8 __attribute__((ext_vector_type(8)));
typedef GAS unsigned gu32;
#define RLX_AGENT __ATOMIC_RELAXED, __HIP_MEMORY_SCOPE_AGENT
#define LDS_WAIT() asm volatile("s_waitcnt lgkmcnt(0)" ::: "memory")
#define VM_WAIT() asm volatile("s_waitcnt vmcnt(0)" ::: "memory")
__device__ __forceinline__ unsigned f2bf(float f) { unsigned u = __builtin_bit_cast(unsigned, f); return (u + 0x7fffu + ((u >> 16) & 1u)) >> 16; }
__device__ __forceinline__ unsigned pk2(float lo, float hi) { return f2bf(lo) | (f2bf(hi) << 16); }
__device__ __forceinline__ float bflo(unsigned w) { return __uint_as_float(w << 16); }
__device__ __forceinline__ float bfhi(unsigned w) { return __uint_as_float(w & 0xffff0000u); }
__device__ __forceinline__ int ld_agent(const int* p) { return (int)__hip_atomic_load((const unsigned*)p, RLX_AGENT); }

#define XB_TMO      128
#define XB_XCNT(j)  (256  + 64 * (j))
#define XB_XSUB(j)  (1280 + 64 * (j))
#define XB_XGEN(j)  (2304 + 64 * (j))
#define XB_TOP      3328
#define XB_TOPGEN   3392
#define XCD_BAR_WORDS 3456
#define XB_SPIN_CAP (1u << 22)

__device__ __forceinline__ unsigned xb_ld(unsigned* p)              { return __hip_atomic_load(p, __ATOMIC_RELAXED, __HIP_MEMORY_SCOPE_AGENT); }
__device__ __forceinline__ unsigned xb_add(unsigned* p, unsigned v) { return __hip_atomic_fetch_add(p, v, __ATOMIC_RELAXED, __HIP_MEMORY_SCOPE_AGENT); }
__device__ __forceinline__ unsigned xb_xcc_id() { return (unsigned)__builtin_amdgcn_s_getreg((3 << 11) | 20) & 0xFu; }
#define XB_SPIN(cond, bar) do { unsigned _sp = 0; while (cond) { __builtin_amdgcn_s_sleep(1); \
    if ((++_sp & 255u) == 0u) { if (xb_ld(&(bar)[XB_TMO])) break; if (_sp > XB_SPIN_CAP) { atomicAdd(&(bar)[XB_TMO], 1u); break; } } } } while (0)

struct XcdBarrier { unsigned* bar; unsigned x; volatile LAS unsigned* st; };

__device__ __forceinline__ XcdBarrier xcd_barrier_post(unsigned* bar, volatile LAS unsigned* st) {
    XcdBarrier b; b.bar = bar; b.x = xb_xcc_id(); b.st = st;
    if (threadIdx.x == 0) (void)xb_add(&bar[XB_XCNT(b.x)], 1u);
    return b;
}
__device__ __forceinline__ void xcd_barrier_complete(unsigned* bar, unsigned x, unsigned& nloc, unsigned& nx) {
    const unsigned G = gridDim.x * gridDim.y * gridDim.z;
    unsigned sum, cnt, mine, sp = 0u;
    for (;;) {
        sum = 0u; cnt = 0u; mine = 0u;
#pragma unroll
        for (unsigned j = 0; j < 16; ++j) { const unsigned c = xb_ld(&bar[XB_XCNT(j)]); sum += c; cnt += (c > 0u) ? 1u : 0u; mine = (j == x) ? c : mine; }
        if (sum == G) break;
        __builtin_amdgcn_s_sleep(1);
        if ((++sp & 255u) == 0u) { if (xb_ld(&bar[XB_TMO])) break; if (sp > XB_SPIN_CAP) { atomicAdd(&bar[XB_TMO], 1u); break; } }
    }
    nloc = mine > 0u ? mine : 1u; nx = cnt > 0u ? cnt : 1u;
}
__device__ __forceinline__ void xcd_barrier(const XcdBarrier& b) {
    asm volatile("s_waitcnt vmcnt(0)" ::: "memory");
    __syncthreads();
    if (threadIdx.x == 0) {
        unsigned* bar = b.bar;
        __builtin_amdgcn_s_waitcnt(0);
        unsigned nloc = b.st[0], nx = b.st[1];
        if (nloc == 0u) { xcd_barrier_complete(bar, b.x, nloc, nx); b.st[0] = nloc; b.st[1] = nx; }
        const unsigned old = xb_add(&bar[XB_XSUB(b.x)], 1u);
        const unsigned gen = old / nloc;
        if (old + 1u == (gen + 1u) * nloc) {
            __builtin_amdgcn_fence(__ATOMIC_RELEASE, "agent");
            asm volatile("s_waitcnt vmcnt(0)" ::: "memory");
            const unsigned og = xb_add(&bar[XB_TOP], 1u);
            const unsigned tg = og / nx;
            if (og + 1u == (tg + 1u) * nx) xb_add(&bar[XB_TOPGEN], 1u);
            else XB_SPIN(xb_ld(&bar[XB_TOPGEN]) == tg, bar);
            __builtin_amdgcn_fence(__ATOMIC_ACQUIRE, "agent");
            xb_add(&bar[XB_XGEN(b.x)], 1u);
            asm volatile("s_waitcnt vmcnt(0)" ::: "memory");
        } else {
            XB_SPIN(xb_ld(&bar[XB_XGEN(b.x)]) == gen, bar);
            __builtin_amdgcn_fence(__ATOMIC_ACQUIRE, "agent");
            asm volatile("s_waitcnt vmcnt(0)" ::: "memory");
        }
    }
    __syncthreads();
}

struct Frame { LAS unsigned char* lds; int wave, vcu, G; };
struct Args { const float* in[29]; float* out; unsigned char* ws; };
typedef __attribute__((address_space(4))) const unsigned char* kargp_t;
__device__ __forceinline__ kargp_t kargs() { kargp_t p = (kargp_t)__builtin_amdgcn_kernarg_segment_ptr(); asm volatile("" : "+s"(p)); return p; }
__device__ __forceinline__ const float* kin(int i) { return *(const float* const __attribute__((address_space(4)))*)(kargs() + 8 * i); }
__device__ __forceinline__ float* kout() { return *(float* const __attribute__((address_space(4)))*)(kargs() + 8 * 29); }
__device__ __forceinline__ unsigned char* kws() { return *(unsigned char* const __attribute__((address_space(4)))*)(kargs() + 8 * 30); }

__device__ __forceinline__ float wave_sum(float v) {
#define WS_STEP(M) v += __uint_as_float((unsigned)__builtin_amdgcn_ds_swizzle((int)__float_as_uint(v), ((M) << 10) | 0x1F))
    WS_STEP(1); WS_STEP(2); WS_STEP(4); WS_STEP(8); WS_STEP(16);
#undef WS_STEP
    { auto rr = __builtin_amdgcn_permlane32_swap(__float_as_uint(v), __float_as_uint(v), false, false); v = __uint_as_float(rr[0]) + __uint_as_float(rr[1]); }
    return v;
}

template <class ColF> __device__ __forceinline__ void transpose_item(const float* W, int ldw, int k0, ColF colf, bf16* WT, int Kd, int drow0, LAS float* scr, int lane) {
    const int j = lane & 31; const int sc = colf(j);
    float tv[32];
#pragma unroll
    for (int i = 0; i < 32; ++i) tv[i] = W[(size_t)(k0 + 2 * i + (lane >> 5)) * ldw + sc];
#pragma unroll
    for (int i = 0; i < 32; ++i) scr[(2 * i + (lane >> 5)) * 33 + j] = tv[i];
    LDS_WAIT(); asm volatile("" ::: "memory");
    const int c = lane & 7;
#pragma unroll
    for (int jj = 0; jj < 4; ++jj) { const int n = (lane >> 3) + 8 * jj; const LAS float* s = scr + (8 * c) * 33 + n;
        v4u o; o.x = pk2(s[0 * 33], s[1 * 33]); o.y = pk2(s[2 * 33], s[3 * 33]); o.z = pk2(s[4 * 33], s[5 * 33]); o.w = pk2(s[6 * 33], s[7 * 33]);
        *(GAS v4u*)(WT + (size_t)(drow0 + n) * Kd + k0 + 8 * c) = o; }
    LDS_WAIT(); asm volatile("" ::: "memory");
}
struct ColId { int c0; __device__ __forceinline__ int operator()(int j) const { return c0 + j; } };
struct ColQK { int n0; __device__ __forceinline__ int operator()(int j) const { const int n = n0 + j; if (n >= 2048) return n; const int hb = n >> 6, p = n & 63, g = p >> 3, i = p & 7;
    return 64 * hb + (i < 4 ? 4 * g + i : 32 + 4 * g + (i - 4)); } };

struct CvI { const float* W; int ldw, k0, c0; bf16* WT; int Kd, drow0; };
__device__ __forceinline__ CvI cv_item(int it, int l, bf16* base) {
    constexpr int PER_E = 256 + 128; CvI I;
    const int e = it / PER_E; int r = it % PER_E;
    if (r < 256) { const int kb = r >> 4, nb = r & 15; const int pn = nb >> 3, rr = (nb & 7) * 32; const bool up = rr >= 128;
        I.W = e < 64 ? (up ? kin(23) : kin(22)) + ((size_t)l * 64 + e) * 1024 * 256 : (up ? kin(26) : kin(25)) + (size_t)l * 1024 * 256;
        I.ldw = 256; I.k0 = kb * 64; I.c0 = 128 * pn + (up ? rr - 128 : rr); I.WT = base; I.Kd = 1024; I.drow0 = e * 512 + nb * 32;
    } else { r -= 256; const int kb = r >> 5, nb = r & 31;
        I.W = e < 64 ? kin(24) + ((size_t)l * 64 + e) * 256 * 1024 : kin(27) + (size_t)l * 256 * 1024;
        I.ldw = 1024; I.k0 = kb * 64; I.c0 = nb * 32; I.WT = base + (size_t)65 * 512 * 1024; I.Kd = 256; I.drow0 = e * 1024 + nb * 32; }
    return I;
}
__device__ __forceinline__ void cv_load(const CvI& I, float (&tv)[32], int lane) {
    const int sc = I.c0 + (lane & 31);
#pragma unroll
    for (int i = 0; i < 32; ++i) tv[i] = I.W[(size_t)(I.k0 + 2 * i + (lane >> 5)) * I.ldw + sc];
}
__device__ __forceinline__ void cv_store(const CvI& I, const float (&tv)[32], LAS float* scr, int lane) {
    const int j = lane & 31;
#pragma unroll
    for (int i = 0; i < 32; ++i) scr[(2 * i + (lane >> 5)) * 33 + j] = tv[i];
    LDS_WAIT(); asm volatile("" ::: "memory");
    const int c = lane & 7;
#pragma unroll
    for (int jj = 0; jj < 4; ++jj) { const int n = (lane >> 3) + 8 * jj; const LAS float* sp = scr + (8 * c) * 33 + n;
        v4u o; o.x = pk2(sp[0 * 33], sp[1 * 33]); o.y = pk2(sp[2 * 33], sp[3 * 33]); o.z = pk2(sp[4 * 33], sp[5 * 33]); o.w = pk2(sp[6 * 33], sp[7 * 33]);
        *(GAS v4u*)(I.WT + (size_t)(I.drow0 + n) * I.Kd + I.k0 + 8 * c) = o; }
    LDS_WAIT(); asm volatile("" ::: "memory");
}
constexpr int CV_NITEMS = 65 * 384;
__device__ __forceinline__ void convert_moe_weights(const Frame& F, int l, bf16* base, int it0, int it1, int gw, int NGW) {
    LAS float* scr = (LAS float*)(F.lds + F.wave * 17408);
    const int lane = (opq((int)threadIdx.x) & 63);
#pragma unroll 1
    for (int it = it0 + gw; it < it1; it += 2 * NGW) {
        const bool hb = it + NGW < it1;
        const CvI A = cv_item(it, l, base), B = cv_item(hb ? it + NGW : it, l, base);
        float ta[32], tb[32];
        cv_load(A, ta, lane); if (hb) cv_load(B, tb, lane);
        cv_store(A, ta, scr, lane); if (hb) cv_store(B, tb, scr + 64 * 33, lane);
    }
}

__constant__ float c_inv_freq[32] = {
    1.000000000e+00f, 7.498942614e-01f, 5.623413324e-01f, 4.216965139e-01f, 3.162277639e-01f, 2.371373773e-01f, 1.778279394e-01f, 1.333521307e-01f,
    1.000000015e-01f, 7.498941571e-02f, 5.623413250e-02f, 4.216965288e-02f, 3.162277490e-02f, 2.371373773e-02f, 1.778279431e-02f, 1.333521493e-02f,
    9.999999776e-03f, 7.498941850e-03f, 5.623413250e-03f, 4.216964822e-03f, 3.162277630e-03f, 2.371373586e-03f, 1.778279431e-03f, 1.333521446e-03f,
    1.000000047e-03f, 7.498942432e-04f, 5.623413017e-04f, 4.216965172e-04f, 3.162277571e-04f, 2.371373703e-04f, 1.778279402e-04f, 1.333521504e-04f };

__device__ __forceinline__ void phase_prologue(const Frame& F, const Args& a) {
    const int tid = opq((int)threadIdx.x), lane = tid & 63, wave = F.wave;
    if (blockIdx.x < 192) {
        LAS float* cond = (LAS float*)F.lds; LAS float* red = (LAS float*)(F.lds + 32768);
        for (int i = tid; i < 8 * 1024; i += 512) { const float c = kin(1)[i]; cond[i] = c / (1.0f + __expf(-c)); }
        __syncthreads();
        const int l = blockIdx.x / 96, jb = blockIdx.x % 96, j = jb * 64 + lane;
        const float* W = kin(5) + (size_t)l * 1024 * 6144;
        float acc[8];
#pragma unroll
        for (int b = 0; b < 8; ++b) acc[b] = 0.f;
#pragma unroll 4
        for (int kk = 0; kk < 128; ++kk) { const int k = wave * 128 + kk; const float wv = W[(size_t)k * 6144 + j];
#pragma unroll
            for (int b = 0; b < 8; ++b) acc[b] += cond[b * 1024 + k] * wv; }
#pragma unroll
        for (int b = 0; b < 8; ++b) red[(wave * 8 + b) * 64 + lane] = acc[b];
        __syncthreads();
        { const int b = tid >> 6; float s = 0.f;
#pragma unroll
          for (int w = 0; w < 8; ++w) s += red[(w * 8 + b) * 64 + lane];
          ((float*)(kws() + WS_MOD))[(size_t)(l * 8 + b) * 6144 + j] = s + kin(6)[l * 6144 + j]; }
        __syncthreads();
    }
    { float* cosT = (float*)(kws() + WS_COS); float* sinT = (float*)(kws() + WS_SIN); const int* pos = (const int*)kin(2);
      for (int i = blockIdx.x * 512 + tid; i < T * 32; i += F.G * 512) { const int t = i >> 5, j = i & 31;
          const float ang = (float)pos[t] * c_inv_freq[j];
          const double rev = (double)ang * 0.15915494309189535; const float fr = (float)(rev - __builtin_rint(rev));
          cosT[i] = __builtin_amdgcn_cosf(fr); sinT[i] = __builtin_amdgcn_sinf(fr); } }
    { bf16* wsb = (bf16*)(kws() + WS_WSB); for (int i = blockIdx.x * 512 + tid; i < 8 * 128 * 128; i += F.G * 512) wsb[i] = (bf16)f2bf(kin(17)[i]); }
    { bf16* wrt = (bf16*)(kws() + WS_WRT); for (int i = blockIdx.x * 512 + tid; i < 2 * 1024 * 64; i += F.G * 512) { const int l = i >> 16, k = (i >> 6) & 1023, e = i & 63;
        const float w = kin(20)[i]; const unsigned hi = f2bf(w); const unsigned lo = f2bf(w - __uint_as_float(hi << 16));
        wrt[((size_t)(l * 2 + 0) * 64 + e) * 1024 + k] = (bf16)hi; wrt[((size_t)(l * 2 + 1) * 64 + e) * 1024 + k] = (bf16)lo; } }
    LAS float* scr = (LAS float*)(F.lds + wave * 17408);
    const int gw = F.vcu * NWAVES + wave, NGW = F.G * NWAVES;
    constexpr int I_QKV = 16 * 96, I_WO = 16 * 32, I_SGIN = 16 * 128, I_SGOUT = 32 * 32;
    for (int it = gw; it < I_QKV + I_WO + I_SGIN + I_SGOUT; it += NGW) {
        int r = it;
        if (r < I_QKV) { const int kb = r / 96, nb = r % 96; transpose_item(kin(7), 3072, kb * 64, ColQK{nb * 32}, (bf16*)(kws() + WS_WQKV), 1024, nb * 32, scr, lane); continue; } r -= I_QKV;
        if (r < I_WO) { const int kb = r / 32, nb = r % 32; transpose_item(kin(13), 1024, kb * 64, ColId{nb * 32}, (bf16*)(kws() + WS_WO), 1024, nb * 32, scr, lane); continue; } r -= I_WO;
        if (r < I_SGIN) { const int kb = r / 128, nb = r % 128; transpose_item(kin(14), 4096, kb * 64, ColId{nb * 32}, (bf16*)(kws() + WS_WSGIN), 1024, nb * 32, scr, lane); continue; } r -= I_SGIN;
        { const int kb = r / 32, nb = r % 32; transpose_item(kin(19), 1024, kb * 64, ColId{nb * 32}, (bf16*)(kws() + WS_WSGOUT), 2048, nb * 32, scr, lane); }
    }
    convert_moe_weights(F, 0, (bf16*)((unsigned char*)kout() + CV_OUT_OFF), 0, CV_NITEMS, F.vcu * NWAVES + wave, F.G * NWAVES);
    __syncthreads();
}

__device__ __forceinline__ void phase_norm(const Frame& F, const float* x, const float* ng, const float* shift, const float* scale, bf16* H) {
    const int gw = F.vcu * NWAVES + F.wave, NGW = F.G * NWAVES, lane = (opq((int)threadIdx.x) & 63);
    f32x4 g4[4];
#pragma unroll
    for (int j = 0; j < 4; ++j) g4[j] = *(const f32x4*)(ng + 4 * lane + 256 * j);
    for (int row = 2 * gw; row < T; row += 2 * NGW) { const int b = row / SEQ;
        f32x4 v[2][4], sc4[4], sh4[4];
#pragma unroll
        for (int r2 = 0; r2 < 2; ++r2) { const GAS f32x4* xr = (const GAS f32x4*)(x + (size_t)(row + r2) * 1024) + lane;
#pragma unroll
            for (int j = 0; j < 4; ++j) v[r2][j] = xr[64 * j]; }
#pragma unroll
        for (int j = 0; j < 4; ++j) { const int col = 4 * lane + 256 * j; sc4[j] = *(const f32x4*)(scale + (size_t)b * 6144 + col); sh4[j] = *(const f32x4*)(shift + (size_t)b * 6144 + col); }
        float ss0 = 0.f, ss1 = 0.f;
#pragma unroll
        for (int j = 0; j < 4; ++j) { ss0 += (v[0][j].x * v[0][j].x + v[0][j].y * v[0][j].y) + (v[0][j].z * v[0][j].z + v[0][j].w * v[0][j].w);
                                      ss1 += (v[1][j].x * v[1][j].x + v[1][j].y * v[1][j].y) + (v[1][j].z * v[1][j].z + v[1][j].w * v[1][j].w); }
        const float rstd0 = 1.0f / sqrtf(wave_sum(ss0) * (1.0f / 1024.0f) + EPS), rstd1 = 1.0f / sqrtf(wave_sum(ss1) * (1.0f / 1024.0f) + EPS);
#pragma unroll
        for (int r2 = 0; r2 < 2; ++r2) { const float rstd = r2 == 0 ? rstd0 : rstd1; GAS v2u* o8 = (GAS v2u*)(H + (size_t)(row + r2) * 1024) + lane;
#pragma unroll
            for (int j = 0; j < 4; ++j) { const f32x4 h = v[r2][j] * rstd * g4[j] * (sc4[j] + 1.0f) + sh4[j];
                v2u w; w.x = pk2(h.x, h.y); w.y = pk2(h.z, h.w); o8[64 * j] = w; } }
    }
}

__device__ __forceinline__ void phase_attn(const Frame& F, const bf16* Q, const bf16* K, const bf16* V, bf16* Ob, char* lds) {
    const int lane = (opq((int)threadIdx.x) & 63);
    const float s1 = wave_sum(kin(8)[lane] * kin(9)[lane]), s2 = wave_sum(kin(10)[lane] * kin(11)[lane]);
    const float lam = __uint_as_float(__builtin_amdgcn_readfirstlane(__float_as_uint(__expf(s1) - __expf(s2) + 0.2f)));
    for (int U = F.vcu; U < BATCH * 8 * 32; U += F.G) { const int bh = U >> 5, qb = U & 31, b = bh >> 3, h = bh & 7;
        const size_t row0 = (size_t)b * SEQ + (size_t)qb * 256;
        att::attn_pair_unit(Q + row0 * 1024 + h * 128, K + (size_t)b * SEQ * 1024 + h * 128, V + (size_t)b * SEQ * 1024 + h * 128, Ob + row0 * 1024 + h * 128, SEQ, lds, lam, kin(12));
    }
}

__device__ __forceinline__ void phase_diff(const Frame& F, const Args& a, const bf16* OS, bf16* Ob) {
    const int gw = F.vcu * NWAVES + F.wave, NGW = F.G * NWAVES, lane = (opq((int)threadIdx.x) & 63);
    const float s1 = wave_sum(kin(8)[lane] * kin(9)[lane]), s2 = wave_sum(kin(10)[lane] * kin(11)[lane]);
    const float lam = __expf(s1) - __expf(s2) + 0.2f;
    const float g0 = kin(12)[2 * lane] * 0.8f, g1 = kin(12)[2 * lane + 1] * 0.8f;
    for (int row = 2 * gw; row < T; row += 2 * NGW) {
        unsigned wa[2][8], wb[2][8];
#pragma unroll
        for (int r2 = 0; r2 < 2; ++r2) { const GAS unsigned* src = (const GAS unsigned*)(OS + (size_t)(row + r2) * 2048) + lane;
#pragma unroll
            for (int h = 0; h < 8; ++h) { wa[r2][h] = src[(2 * h) * 64]; wb[r2][h] = src[(2 * h + 1) * 64]; } }
#pragma unroll
        for (int r2 = 0; r2 < 2; ++r2) { GAS unsigned* dst = (GAS unsigned*)(Ob + (size_t)(row + r2) * 1024) + lane;
#pragma unroll
            for (int h = 0; h < 8; ++h) { const float d0 = bflo(wa[r2][h]) - lam * bflo(wb[r2][h]), d1 = bfhi(wa[r2][h]) - lam * bfhi(wb[r2][h]);
                const float r = 1.0f / sqrtf(wave_sum(d0 * d0 + d1 * d1) * (1.0f / 128.0f) + EPS);
                dst[h * 64] = pk2(d0 * r * g0, d1 * r * g1); } }
    }
}

__device__ __forceinline__ int rt_expert(int i) { return 32 * (i >> 5) + 16 * ((i >> 2) & 1) + (i & 3) + 4 * ((i & 31) >> 3); }
__device__ __forceinline__ void router_precompute(const Frame& F) {
    const int tid = opq((int)threadIdx.x), lane = tid & 63;
    const float* modp = (const float*)(kws() + WS_MOD);
    bf16* WrP = (bf16*)(kws() + WS_WRP); float* rc = (float*)(kws() + WS_RC);
    for (int it = F.vcu * 512 + tid; it < 2 * 8 * 64 * 128; it += F.G * 512) {
        const int kc = it & 127, i = (it >> 7) & 63, b = (it >> 13) & 7, l = it >> 16, e = rt_expert(i);
        const float* wr = kin(20) + (size_t)l * 1024 * 64 + e; const float* g = kin(4) + l * 1024; const float* sc = modp + ((size_t)l * 8 + b) * 6144 + 4 * 1024;
        unsigned hi[4], lo[4];
#pragma unroll
        for (int j = 0; j < 4; ++j) { const int k = 8 * kc + 2 * j;
            const float v0 = g[k] * (sc[k] + 1.0f) * wr[(size_t)k * 64], v1 = g[k + 1] * (sc[k + 1] + 1.0f) * wr[(size_t)(k + 1) * 64];
            hi[j] = pk2(v0, v1); lo[j] = pk2(v0 - bflo(hi[j]), v1 - bfhi(hi[j])); }
        bf16* dst = WrP + ((((size_t)l * 8 + b) * 2) * 64 + i) * 1024 + 8 * kc;
        *(GAS v4u*)dst = (v4u){hi[0], hi[1], hi[2], hi[3]}; *(GAS v4u*)(dst + 64 * 1024) = (v4u){lo[0], lo[1], lo[2], lo[3]};
    }
    for (int o = F.vcu * NWAVES + F.wave; o < 2 * 8 * 64; o += F.G * NWAVES) { const int e = o & 63, b = (o >> 6) & 7, l = o >> 9;
        const float* wr = kin(20) + (size_t)l * 1024 * 64 + e; const float* sh = modp + ((size_t)l * 8 + b) * 6144 + 3 * 1024;
        float s = 0.f;
#pragma unroll
        for (int j = 0; j < 16; ++j) { const int k = lane + 64 * j; s += sh[k] * wr[(size_t)k * 64]; }
        s = wave_sum(s); if (lane == 0) rc[o] = s; }
}

__device__ __forceinline__ void phase_norm_router(const Frame& F, const bf16* x, const float* ng, const float* modl, const bf16* WrP, const float* rc, const float* rbias,
                                                  bf16* H2, int* a_e, int* a_pos, float* a_w, gu32* gcount) {
    const int tid = opq((int)threadIdx.x), lane = tid & 63, wave = F.wave, mi = lane & 31, kh = lane >> 5;
    LAS float* rstd_s = (LAS float*)F.lds;
    LAS int* hist = (LAS int*)(F.lds + 1024);
    LAS int* base = hist + 64;
    LAS float* cb = (LAS float*)(base + 64);
    LAS float* rb = cb + 64;
    LAS int* se = (LAS int*)(F.lds + 4096);
    LAS float* ssc = (LAS float*)(se + 1536);
    LAS int* slp = (LAS int*)(ssc + 1536);
    for (int blk = F.vcu; blk < T / 256; blk += F.G) { const int row0 = blk * 256, b = row0 / SEQ, r0 = row0 + wave * 32;
        if (tid < 64) { hist[tid] = 0; cb[tid] = rc[b * 64 + tid]; rb[tid] = rbias[tid]; }
        __syncthreads();
        {
            f32x4 A4[2][2], S4[2][2];
#pragma unroll
            for (int j = 0; j < 2; ++j)
#pragma unroll
                for (int q = 0; q < 2; ++q) { const int col = 8 * lane + 512 * j + 4 * q;
                    A4[j][q] = *(const f32x4*)(ng + col) * (*(const f32x4*)(modl + (size_t)b * 6144 + 4 * 1024 + col) + 1.0f); S4[j][q] = *(const f32x4*)(modl + (size_t)b * 6144 + 3 * 1024 + col); }
            v4u xw[2][2];
#pragma unroll
            for (int r2 = 0; r2 < 2; ++r2)
#pragma unroll
                for (int j = 0; j < 2; ++j) xw[r2][j] = *(const GAS v4u*)(x + (size_t)(r0 + r2) * 1024 + 8 * lane + 512 * j);
#pragma unroll 1
            for (int it = 0; it < 16; ++it) {
                v4u xn[2][2]; const int rn = r0 + (it < 15 ? 2 * it + 2 : 2 * it);
#pragma unroll
                for (int r2 = 0; r2 < 2; ++r2)
#pragma unroll
                    for (int j = 0; j < 2; ++j) xn[r2][j] = *(const GAS v4u*)(x + (size_t)(rn + r2) * 1024 + 8 * lane + 512 * j);
                f32x4 v[2][2][2]; float ss[2];
#pragma unroll
                for (int r2 = 0; r2 < 2; ++r2) { float s = 0.f;
#pragma unroll
                    for (int j = 0; j < 2; ++j) { const v4u w = xw[r2][j];
                        v[r2][j][0] = (f32x4){bflo(w.x), bfhi(w.x), bflo(w.y), bfhi(w.y)}; v[r2][j][1] = (f32x4){bflo(w.z), bfhi(w.z), bflo(w.w), bfhi(w.w)};
#pragma unroll
                        for (int q = 0; q < 2; ++q) s += (v[r2][j][q].x * v[r2][j][q].x + v[r2][j][q].y * v[r2][j][q].y) + (v[r2][j][q].z * v[r2][j][q].z + v[r2][j][q].w * v[r2][j][q].w); }
                    ss[r2] = s; }
                const float rstd0 = 1.0f / sqrtf(wave_sum(ss[0]) * (1.0f / 1024.0f) + EPS), rstd1 = 1.0f / sqrtf(wave_sum(ss[1]) * (1.0f / 1024.0f) + EPS);
#pragma unroll
                for (int r2 = 0; r2 < 2; ++r2) { const int row = r0 + 2 * it + r2; const float rstd = r2 == 0 ? rstd0 : rstd1;
#pragma unroll
                    for (int j = 0; j < 2; ++j) { const int col = 8 * lane + 512 * j;
                        const f32x4 h0 = v[r2][j][0] * rstd * A4[j][0] + S4[j][0], h1 = v[r2][j][1] * rstd * A4[j][1] + S4[j][1];
                        v4u w; w.x = pk2(h0.x, h0.y); w.y = pk2(h0.z, h0.w); w.z = pk2(h1.x, h1.y); w.w = pk2(h1.z, h1.w);
                        *(GAS v4u*)(H2 + (size_t)row * 1024 + col) = w; } }
                if (lane == 0) { rstd_s[wave * 32 + 2 * it] = rstd0; rstd_s[wave * 32 + 2 * it + 1] = rstd1; }
#pragma unroll
                for (int r2 = 0; r2 < 2; ++r2)
#pragma unroll
                    for (int j = 0; j < 2; ++j) xw[r2][j] = xn[r2][j];
            }
        }
        f32x16 acc0, acc1;
        { float zf = 0.f; asm volatile("" : "+v"(zf));
#pragma unroll
          for (int r = 0; r < 16; ++r) { acc0[r] = zf; acc1[r] = zf; } }
        {
            const GAS bf16* xp = (const GAS bf16*)(x + (size_t)(r0 + mi) * 1024 + 8 * kh);
            const GAS bf16* wp = (const GAS bf16*)(WrP + ((size_t)b * 128 + mi) * 1024 + 8 * kh);
            bf16x8 xf[8], wf[8][4];
#define RT_LOAD(j, s) do { const int s_ = (s); xf[j] = *(const GAS bf16x8*)(xp + 16 * s_); wf[j][0] = *(const GAS bf16x8*)(wp + 16 * s_); wf[j][1] = *(const GAS bf16x8*)(wp + 16 * s_ + 32 * 1024); \
        wf[j][2] = *(const GAS bf16x8*)(wp + 16 * s_ + 64 * 1024); wf[j][3] = *(const GAS bf16x8*)(wp + 16 * s_ + 96 * 1024); } while (0)
#pragma unroll
            for (int j = 0; j < 8; ++j) { RT_LOAD(j, j); __builtin_amdgcn_sched_barrier(0); }
#pragma unroll 1
            for (int s = 0; s < 64; s += 8) {
#pragma unroll
                for (int j = 0; j < 8; ++j) {
                    acc0 = __builtin_amdgcn_mfma_f32_32x32x16_bf16(wf[j][0], xf[j], acc0, 0, 0, 0); acc1 = __builtin_amdgcn_mfma_f32_32x32x16_bf16(wf[j][1], xf[j], acc1, 0, 0, 0);
                    acc0 = __builtin_amdgcn_mfma_f32_32x32x16_bf16(wf[j][2], xf[j], acc0, 0, 0, 0); acc1 = __builtin_amdgcn_mfma_f32_32x32x16_bf16(wf[j][3], xf[j], acc1, 0, 0, 0);
                    const int sn = s + 8 + j < 64 ? s + 8 + j : 63;
                    RT_LOAD(j, sn); __builtin_amdgcn_sched_barrier(0);
                }
            }
#undef RT_LOAD
        }
        asm volatile("s_waitcnt lgkmcnt(0)" ::: "memory");
        const float rstd = rstd_s[wave * 32 + mi];
        float sc[32], sl[32];
#pragma unroll
        for (int q = 0; q < 4; ++q) { const f32x4 c0 = *(const LAS f32x4*)(cb + 16 * kh + 4 * q), b0 = *(const LAS f32x4*)(rb + 16 * kh + 4 * q);
            const f32x4 c1 = *(const LAS f32x4*)(cb + 32 + 16 * kh + 4 * q), b1 = *(const LAS f32x4*)(rb + 32 + 16 * kh + 4 * q);
#pragma unroll
            for (int jj = 0; jj < 4; ++jj) { const int r = 4 * q + jj;
                const float s0 = 1.0f / (1.0f + __expf(-(acc0[r] * rstd + c0[jj]))), s1 = 1.0f / (1.0f + __expf(-(acc1[r] * rstd + c1[jj])));
                sc[r] = s0; sl[r] = s0 + b0[jj]; sc[16 + r] = s1; sl[16 + r] = s1 + b1[jj]; } }
        float gl[4];
#pragma unroll
        for (int q = 0; q < 4; ++q) { float m1 = -INFINITY, m2 = -INFINITY;
#pragma unroll
            for (int j = 0; j < 8; ++j) { const float v = sl[8 * q + j]; m2 = fmaxf(m2, fminf(m1, v)); m1 = fmaxf(m1, v); }
            gl[q] = m1 + m2; }
        float G[8];
        { auto r0_ = __builtin_amdgcn_permlane32_swap(__float_as_uint(gl[0]), __float_as_uint(gl[0]), false, false); G[0] = __uint_as_float(r0_[0]); G[2] = __uint_as_float(r0_[1]);
          auto r1_ = __builtin_amdgcn_permlane32_swap(__float_as_uint(gl[1]), __float_as_uint(gl[1]), false, false); G[1] = __uint_as_float(r1_[0]); G[3] = __uint_as_float(r1_[1]);
          auto r2_ = __builtin_amdgcn_permlane32_swap(__float_as_uint(gl[2]), __float_as_uint(gl[2]), false, false); G[4] = __uint_as_float(r2_[0]); G[6] = __uint_as_float(r2_[1]);
          auto r3_ = __builtin_amdgcn_permlane32_swap(__float_as_uint(gl[3]), __float_as_uint(gl[3]), false, false); G[5] = __uint_as_float(r3_[0]); G[7] = __uint_as_float(r3_[1]); }
        bool gsel[8];
#pragma unroll
        for (int g = 0; g < 8; ++g) { int rank = 0;
#pragma unroll
            for (int j = 0; j < 8; ++j) if (j != g) rank += (G[j] > G[g] || (G[j] == G[g] && j < g)) ? 1 : 0;
            gsel[g] = rank < 4; }
        { const bool f0 = kh ? gsel[2] : gsel[0], f1 = kh ? gsel[3] : gsel[1], f2 = kh ? gsel[6] : gsel[4], f3 = kh ? gsel[7] : gsel[5];
#pragma unroll
          for (int j = 0; j < 8; ++j) { sl[j] = f0 ? sl[j] : -INFINITY; sl[8 + j] = f1 ? sl[8 + j] : -INFINITY; sl[16 + j] = f2 ? sl[16 + j] : -INFINITY; sl[24 + j] = f3 ? sl[24 + j] : -INFINITY; } }
        int we[6]; float wsc[6]; float wsum = 0.f;
#pragma unroll
        for (int k = 0; k < 6; ++k) {
            float bv = -INFINITY, bs = 0.f; int bi = 0;
#pragma unroll
            for (int r = 0; r < 32; ++r) { const bool t = sl[r] > bv; bv = t ? sl[r] : bv; bi = t ? r : bi; bs = t ? sc[r] : bs; }
            const int be = 16 * kh + bi + (bi & 16);
            const auto rv = __builtin_amdgcn_permlane32_swap(__float_as_uint(bv), __float_as_uint(bv), false, false);
            const auto re = __builtin_amdgcn_permlane32_swap((unsigned)be, (unsigned)be, false, false);
            const auto rs = __builtin_amdgcn_permlane32_swap(__float_as_uint(bs), __float_as_uint(bs), false, false);
            const float lv = __uint_as_float(rv[0]), uv = __uint_as_float(rv[1]); const int le = (int)re[0], ue = (int)re[1];
            const bool lw = lv > uv || (lv == uv && le < ue);
            const int e = lw ? le : ue; we[k] = e; wsc[k] = lw ? __uint_as_float(rs[0]) : __uint_as_float(rs[1]); wsum += wsc[k];
            const int wr_ = (((e >> 4) & 1) == kh) ? ((e & 15) | ((e & 32) >> 1)) : -1;
#pragma unroll
            for (int r = 0; r < 32; ++r) sl[r] = (r == wr_) ? -INFINITY : sl[r];
        }
#pragma unroll
        for (int j = 0; j < 3; ++j) { const int e = (kh ? we[3 + j] : we[j]) & 63; const float w = (kh ? wsc[3 + j] : wsc[j]) / wsum * 2.5f;
            const int p = atomicAdd((int*)&hist[e], 1);
            const int o = (wave * 32 + mi) * 6 + 3 * kh + j; se[o] = e; ssc[o] = w; slp[o] = p; }
        __syncthreads();
        if (tid < 64) { const int c = hist[tid]; base[tid] = c ? (int)__hip_atomic_fetch_add(gcount + tid, (unsigned)c, RLX_AGENT) : 0; }
        __syncthreads();
        for (int i = tid; i < 1536; i += 512) { const int e = se[i]; a_e[row0 * 6 + i] = e; a_pos[row0 * 6 + i] = base[e] + slp[i]; a_w[row0 * 6 + i] = ssc[i]; }
        __syncthreads();
    }
}

__device__ __forceinline__ void phase_dispatch(const Frame& F, gu32* gcount, const int* a_e, const int* a_pos, const float* a_w, int* tok_of_slot, float* w_of_slot, int* slot_of, int* tile_e) {
    const int tid = opq((int)threadIdx.x);
    LAS int* cnt = (LAS int*)F.lds; LAS int* toff = cnt + 64; LAS int* ntr_l = toff + 64;
    if (tid < 64) cnt[tid] = (int)__hip_atomic_load(gcount + tid, RLX_AGENT);
    __syncthreads();
    if (tid == 0) { int o = 0; for (int e = 0; e < 64; ++e) { toff[e] = o; o += (cnt[e] + 255) >> 8; } ntr_l[0] = o; }
    __syncthreads();
    for (int ai = blockIdx.x * 512 + tid; ai < TK; ai += F.G * 512) { const int e = a_e[ai] & 63; int slot = T + toff[e] * 256 + a_pos[ai];
        slot = slot < T + MAXRT * 256 ? slot : T + MAXRT * 256 - 1;
        tok_of_slot[slot] = ai / 6; w_of_slot[slot] = a_w[ai]; slot_of[ai] = slot; }
    for (int t = blockIdx.x * 512 + tid; t < T; t += F.G * 512) { tok_of_slot[t] = t; w_of_slot[t] = 1.0f; }
    if (blockIdx.x < 64) { const int e = blockIdx.x, c = cnt[e], ntl = (c + 255) >> 8;
        for (int p = c + tid; p < ntl * 256; p += 512) { tok_of_slot[T + toff[e] * 256 + p] = 0; w_of_slot[T + toff[e] * 256 + p] = 0.f; }
        if (tid < ntl) tile_e[toff[e] + tid] = e; }
    if (blockIdx.x == 0 && tid == 0) tile_e[2048] = ntr_l[0];
    __syncthreads();
}

struct ProbGU {
    static constexpr bool GATHER = true;
    int ntiles, G, c; const int* tok_of_slot; const int* tile_e; const bf16* Wgu;
    __device__ __forceinline__ bool next(int i, pg8::Unit& u) const { const int L = i * G + c; if (L >= 2 * ntiles) return false; u.pm = L >> 1; u.pn = L & 1; return true; }
    __device__ __forceinline__ const char* bbase(const pg8::Unit& u) const { const int e = u.pm < 256 ? 64 : (ld_agent(tile_e + (u.pm - 256)) & 63);
        return (const char*)(Wgu + ((size_t)e * 512 + (size_t)u.pn * 256) * 1024); }
    __device__ __forceinline__ size_t abase(const pg8::Unit& u) const { return 0; }
    __device__ __forceinline__ unsigned arow(const pg8::Unit& u, int r) const { return (unsigned)tok_of_slot[u.pm * 256 + r] & 0xffffu; }
};
struct ProbDown {
    static constexpr bool GATHER = false;
    int ntiles, G, c; const int* tile_e; const bf16* Wd;
    __device__ __forceinline__ bool next(int i, pg8::Unit& u) const { const int L = i * G + c; if (L >= 4 * ntiles) return false; u.pm = L >> 2; u.pn = L & 3; return true; }
    __device__ __forceinline__ const char* bbase(const pg8::Unit& u) const { const int e = u.pm < 256 ? 64 : (ld_agent(tile_e + (u.pm - 256)) & 63);
        return (const char*)(Wd + ((size_t)e * 1024 + (size_t)u.pn * 256) * 256); }
    __device__ __forceinline__ size_t abase(const pg8::Unit& u) const { return (size_t)(u.pm * 256) * 512; }
    __device__ __forceinline__ unsigned arow(const pg8::Unit& u, int r) const { return (unsigned)(u.pm * 256 + r); }
};

__device__ __forceinline__ int clamp_slot(int v) { return v < T ? T : (v >= T + MAXRT * 256 ? T + MAXRT * 256 - 1 : v); }
__device__ __forceinline__ void phase_combine(const Frame& F, int l, const unsigned char* Y, const int* slot_of, bf16* xres, bf16* Hn, float* outf) {
    typedef float f32x2 __attribute__((ext_vector_type(2)));
    const int gw = F.vcu * NWAVES + F.wave, NGW = F.G * NWAVES, lane = (opq((int)threadIdx.x) & 63), c0 = 16 * lane;
    const float* modl = (const float*)(kws() + WS_MOD) + (size_t)l * 8 * 6144;
    int sl[2][6];
    int row = 2 * gw;
    if (row < T) {
#pragma unroll
        for (int r2 = 0; r2 < 2; ++r2)
#pragma unroll
            for (int k = 0; k < 6; ++k) sl[r2][k] = clamp_slot(ld_agent(slot_of + (row + r2) * 6 + k));
    }
    for (; row < T; row += 2 * NGW) { const int b = row / SEQ;
        v4u y[2][7]; v4u xw[2][2];
#pragma unroll
        for (int r2 = 0; r2 < 2; ++r2) {
#pragma unroll
            for (int k = 0; k < 6; ++k) y[r2][k] = __builtin_nontemporal_load((const GAS v4u*)(Y + (size_t)sl[r2][k] * 1024 + c0));
            y[r2][6] = __builtin_nontemporal_load((const GAS v4u*)(Y + (size_t)(row + r2) * 1024 + c0));
#pragma unroll
            for (int j = 0; j < 2; ++j) xw[r2][j] = *(const GAS v4u*)(xres + (size_t)(row + r2) * 1024 + c0 + 8 * j); }
        const int nrow = row + 2 * NGW;
        if (nrow < T) {
#pragma unroll
            for (int r2 = 0; r2 < 2; ++r2)
#pragma unroll
                for (int k = 0; k < 6; ++k) sl[r2][k] = clamp_slot(ld_agent(slot_of + (nrow + r2) * 6 + k));
        }
        f32x4 g[4];
#pragma unroll
        for (int j = 0; j < 4; ++j) g[j] = *(const f32x4*)(modl + (size_t)b * 6144 + 5 * 1024 + c0 + 4 * j) * 0.0625f;
        f32x4 x[2][4]; float ss[2];
#pragma unroll
        for (int r2 = 0; r2 < 2; ++r2) { f32x4 s[4];
#pragma unroll
            for (int j = 0; j < 4; ++j) s[j] = (f32x4){0.f, 0.f, 0.f, 0.f};
#pragma unroll
            for (int k = 0; k < 7; ++k) { const v4u w = y[r2][k];
                { const f32x2 a0 = __builtin_amdgcn_cvt_pk_f32_fp8((int)w.x, false), a1 = __builtin_amdgcn_cvt_pk_f32_fp8((int)w.x, true); s[0] += (f32x4){a0.x, a0.y, a1.x, a1.y}; }
                { const f32x2 a0 = __builtin_amdgcn_cvt_pk_f32_fp8((int)w.y, false), a1 = __builtin_amdgcn_cvt_pk_f32_fp8((int)w.y, true); s[1] += (f32x4){a0.x, a0.y, a1.x, a1.y}; }
                { const f32x2 a0 = __builtin_amdgcn_cvt_pk_f32_fp8((int)w.z, false), a1 = __builtin_amdgcn_cvt_pk_f32_fp8((int)w.z, true); s[2] += (f32x4){a0.x, a0.y, a1.x, a1.y}; }
                { const f32x2 a0 = __builtin_amdgcn_cvt_pk_f32_fp8((int)w.w, false), a1 = __builtin_amdgcn_cvt_pk_f32_fp8((int)w.w, true); s[3] += (f32x4){a0.x, a0.y, a1.x, a1.y}; } }
            { const v4u w0 = xw[r2][0], w1 = xw[r2][1];
              x[r2][0] = (f32x4){bflo(w0.x), bfhi(w0.x), bflo(w0.y), bfhi(w0.y)}; x[r2][1] = (f32x4){bflo(w0.z), bfhi(w0.z), bflo(w0.w), bfhi(w0.w)};
              x[r2][2] = (f32x4){bflo(w1.x), bfhi(w1.x), bflo(w1.y), bfhi(w1.y)}; x[r2][3] = (f32x4){bflo(w1.z), bfhi(w1.z), bflo(w1.w), bfhi(w1.w)}; }
            float q = 0.f;
#pragma unroll
            for (int j = 0; j < 4; ++j) { x[r2][j] += g[j] * s[j]; q += (x[r2][j].x * x[r2][j].x + x[r2][j].y * x[r2][j].y) + (x[r2][j].z * x[r2][j].z + x[r2][j].w * x[r2][j].w); }
            ss[r2] = q; }
        const float rstd0 = 1.0f / sqrtf(wave_sum(ss[0]) * (1.0f / 1024.0f) + EPS), rstd1 = 1.0f / sqrtf(wave_sum(ss[1]) * (1.0f / 1024.0f) + EPS);
        if (l == 0) {
            const float* ng = kin(3) + 1024; const float* m1 = (const float*)(kws() + WS_MOD) + (size_t)(8 + b) * 6144;
#pragma unroll
            for (int r2 = 0; r2 < 2; ++r2) { const float rs = r2 == 0 ? rstd0 : rstd1; unsigned hw[8], xo[8];
#pragma unroll
                for (int j = 0; j < 4; ++j) { xo[2 * j] = pk2(x[r2][j].x, x[r2][j].y); xo[2 * j + 1] = pk2(x[r2][j].z, x[r2][j].w);
                    const f32x4 g4 = *(const f32x4*)(ng + c0 + 4 * j), sc4 = *(const f32x4*)(m1 + 1024 + c0 + 4 * j), sh4 = *(const f32x4*)(m1 + c0 + 4 * j);
                    const f32x4 h = x[r2][j] * rs * g4 * (sc4 + 1.0f) + sh4; hw[2 * j] = pk2(h.x, h.y); hw[2 * j + 1] = pk2(h.z, h.w); }
                GAS v4u* xp = (GAS v4u*)(xres + (size_t)(row + r2) * 1024 + c0);
                xp[0] = (v4u){xo[0], xo[1], xo[2], xo[3]}; xp[1] = (v4u){xo[4], xo[5], xo[6], xo[7]};
                GAS v4u* hp = (GAS v4u*)(Hn + (size_t)(row + r2) * 1024 + c0);
                hp[0] = (v4u){hw[0], hw[1], hw[2], hw[3]}; hp[1] = (v4u){hw[4], hw[5], hw[6], hw[7]}; }
        } else {
            const float* fg = kin(28);
#pragma unroll
            for (int r2 = 0; r2 < 2; ++r2) { const float rs = r2 == 0 ? rstd0 : rstd1;
#pragma unroll
                for (int j = 0; j < 4; ++j) *(f32x4*)(outf + (size_t)(row + r2) * 1024 + c0 + 4 * j) = x[r2][j] * rs * *(const f32x4*)(fg + c0 + 4 * j); }
        }
    }
}

__device__ __forceinline__ void phase_spatial(const Frame& F, const Args& a, const bf16* Z, const bf16* Wsb, bf16* Gout, char* lds) {
    const int tid = opq((int)threadIdx.x), lane = tid & 63, wave = F.wave, r32 = lane & 31, hi = lane >> 5;
    LAS float* stats = (LAS float*)(F.lds + 144384);
    const float* ln_g = kin(15); const float* ln_b = kin(16); const float* b_s = kin(18);
    const int sr = tid >> 4, sc = (tid & 15) * 8;
    const int pb = wave & 3, ch = wave >> 2;
    LAS float* Sw = (LAS float*)(F.lds + wave * 16384);
    for (int chunk = F.vcu; chunk < T / 128; chunk += F.G) { const size_t R0 = (size_t)chunk * 128;
#pragma unroll 1
        for (int rr = 0; rr < 16; rr += 4) {
            v4u w[4][4];
#pragma unroll
            for (int r4 = 0; r4 < 4; ++r4) { const GAS v4u* vp = (const GAS v4u*)(Z + (R0 + wave * 16 + rr + r4) * 4096 + 2048) + lane;
#pragma unroll
                for (int j = 0; j < 4; ++j) w[r4][j] = vp[64 * j]; }
#pragma unroll
            for (int r4 = 0; r4 < 4; ++r4) { float s = 0.f;
#pragma unroll
                for (int j = 0; j < 4; ++j) s += ((bflo(w[r4][j].x) + bfhi(w[r4][j].x)) + (bflo(w[r4][j].y) + bfhi(w[r4][j].y))) + ((bflo(w[r4][j].z) + bfhi(w[r4][j].z)) + (bflo(w[r4][j].w) + bfhi(w[r4][j].w)));
                const float mean = wave_sum(s) * (1.0f / 2048.0f); float qq = 0.f;
#pragma unroll
                for (int j = 0; j < 4; ++j) { const unsigned ww[4] = {w[r4][j].x, w[r4][j].y, w[r4][j].z, w[r4][j].w};
#pragma unroll
                    for (int t = 0; t < 4; ++t) { const float d0 = bflo(ww[t]) - mean, d1 = bfhi(ww[t]) - mean; qq += d0 * d0 + d1 * d1; } }
                const float rstd = 1.0f / sqrtf(wave_sum(qq) * (1.0f / 2048.0f) + EPS);
                if (lane == 0) { const int q = wave * 16 + rr + r4; stats[2 * q] = mean; stats[2 * q + 1] = rstd; } }
        }
        __syncthreads();
#pragma unroll 1
        for (int g = 0; g < 8; ++g) {
            v4u uu[8];
#pragma unroll
            for (int i = 0; i < 8; ++i) uu[i] = *(const GAS v4u*)(Z + (R0 + 32 * pb + 4 * i + (lane >> 4)) * 4096 + g * 256 + 128 * ch + 8 * (lane & 15));
#pragma unroll
            for (int qt = 0; qt < 2; ++qt)
#pragma unroll
                for (int c2 = 0; c2 < 2; ++c2)
#pragma unroll
                    for (int hf = 0; hf < 2; ++hf) { const int ql = sr + 32 * hf, q = 64 * qt + ql, col = g * 256 + 128 * c2 + sc;
                        const v4u w = *(const GAS v4u*)(Z + (R0 + q) * 4096 + 2048 + col);
                        const float mean = stats[2 * q], rstd = stats[2 * q + 1];
                        const f32x4 lg0 = *(const f32x4*)(ln_g + col), lg1 = *(const f32x4*)(ln_g + col + 4), lb0 = *(const f32x4*)(ln_b + col), lb1 = *(const f32x4*)(ln_b + col + 4);
                        v4u o; o.x = pk2((bflo(w.x) - mean) * rstd * lg0.x + lb0.x, (bfhi(w.x) - mean) * rstd * lg0.y + lb0.y);
                        o.y = pk2((bflo(w.y) - mean) * rstd * lg0.z + lb0.z, (bfhi(w.y) - mean) * rstd * lg0.w + lb0.w);
                        o.z = pk2((bflo(w.z) - mean) * rstd * lg1.x + lb1.x, (bfhi(w.z) - mean) * rstd * lg1.y + lb1.y);
                        o.w = pk2((bflo(w.w) - mean) * rstd * lg1.z + lb1.z, (bfhi(w.w) - mean) * rstd * lg1.w + lb1.w);
                        *(LAS v4u*)(F.lds + (qt * 2 + c2) * 16384 + att::v_st(ql, sc)) = o; }
            __syncthreads();
            f32x16 o[4] = {};
#pragma unroll
            for (int qt = 0; qt < 2; ++qt) { bf16x8 pa[4];
#pragma unroll
                for (int ks = 0; ks < 4; ++ks) pa[ks] = *(const bf16x8*)(Wsb + ((size_t)g * 128 + 32 * pb + r32) * 128 + 64 * qt + 16 * ks + 8 * hi);
                att::pv_d0(o, (int)(uintptr_t)(F.lds + (qt * 2 + ch) * 16384) + att::v_rd_base(lane), pa[0], pa[1], pa[2], pa[3]); }
            __syncthreads();
#pragma unroll
            for (int r = 0; r < 16; ++r) { const int pl = att::crow(r, hi); const float bs = b_s[g * 128 + 32 * pb + pl];
#pragma unroll
                for (int d0 = 0; d0 < 4; ++d0) Sw[pl * 128 + 32 * d0 + r32] = o[d0][r] + bs; }
            asm volatile("s_waitcnt lgkmcnt(0)" ::: "memory");
#pragma unroll
            for (int i = 0; i < 8; ++i) { const int pl = 4 * i + (lane >> 4), cl = 8 * (lane & 15);
                const f32x4 s0 = *(const LAS f32x4*)(Sw + pl * 128 + cl), s1 = *(const LAS f32x4*)(Sw + pl * 128 + cl + 4);
                v4u ow; ow.x = pk2(bflo(uu[i].x) * s0.x, bfhi(uu[i].x) * s0.y); ow.y = pk2(bflo(uu[i].y) * s0.z, bfhi(uu[i].y) * s0.w);
                ow.z = pk2(bflo(uu[i].z) * s1.x, bfhi(uu[i].z) * s1.y); ow.w = pk2(bflo(uu[i].w) * s1.z, bfhi(uu[i].w) * s1.w);
                *(GAS v4u*)(Gout + (R0 + 32 * pb + pl) * 2048 + g * 256 + 128 * ch + cl) = ow; }
            __syncthreads();
        }
    }
}

#define ws kws()
#define GRID_BAR() do { XcdBarrier b_; b_.bar = (unsigned*)((gu32*)(kws() + WS_CTL) + CW_BAR); b_.x = xb_xcc_id(); b_.st = (volatile LAS unsigned*)(F.lds + MISC_OFF) + 8; xcd_barrier(b_); } while (0)
#define mod ((float*)(ws + WS_MOD))
#define A0 ((bf16*)kout())
#define XB ((bf16*)(ws + WS_A0))
#define Qb ((bf16*)(ws + WS_Q))
#define Kb ((bf16*)(ws + WS_K))
#define Vb ((bf16*)(ws + WS_V))
#define OS ((bf16*)(ws + WS_OS))
#define HM ((bf16*)(ws + WS_HMOE))
#define Yb ((bf16*)(ws + WS_Y))
#define Zb ((bf16*)(ws + WS_Z))
#define a_e ((int*)(ws + WS_AE))
#define a_pos ((int*)(ws + WS_APOS))
#define a_w ((float*)(ws + WS_AW))
#define tok_of_slot ((int*)(ws + WS_TOK))
#define w_of_slot ((float*)(ws + WS_WSLOT))
#define slot_of ((int*)(ws + WS_SLOTOF))
#define tile_e ((int*)(ws + WS_TILEE))
#define modl (mod + (size_t)l * 8 * 6144)

template <int l> __device__ __forceinline__ void layer_body(const Frame& F, const Args& a, char* ldsg) {
    gu32* ctl = (gu32*)(ws + WS_CTL);
#define modl (mod + (size_t)l * 8 * 6144)
        if (l == 0) {
            { pg8::ProbDense S; S.init(T, 3072, 1024, (const bf16*)(ws + WS_WQKV), F.G, (int)blockIdx.x);
              pg8::EpiQKV E{Qb, (size_t)(WS_K - WS_Q) / 2, (const float*)(ws + WS_COS), (const float*)(ws + WS_SIN), att::QSCALE};

#if PHMASK & 4
              for (int rep = 0; rep < REP_QKV; ++rep) pg8::gemm_phase<pg8::EpiQKV, pg8::ProbDense, true>(F.lds, A0, 1024, S, E);
#endif
            }
            GRID_BAR();
#if PHMASK & 8
            for (int rep = 0; rep < REP_ATT; ++rep) phase_attn(F, Qb, Kb, Vb, A0, ldsg);
#endif
            GRID_BAR();
        } else {
            { pg8::ProbDense S; S.init(T, 4096, 1024, (const bf16*)(ws + WS_WSGIN), F.G, (int)blockIdx.x);
              pg8::EpiBf16<1> E{Zb, 4096};

#if PHMASK & 32
              for (int rep = 0; rep < REP_SGIN; ++rep) pg8::gemm_phase<pg8::EpiBf16<1>, pg8::ProbDense, true>(F.lds, A0, 1024, S, E);
#endif
            }
            GRID_BAR();
#if PHMASK & 64
            for (int rep = 0; rep < REP_SPAT; ++rep) phase_spatial(F, a, Zb, (const bf16*)(ws + WS_WSB), A0, ldsg);
#endif
            GRID_BAR();
        }
        { const int Kp = l == 0 ? 1024 : 2048;
          pg8::ProbDense S; S.init(T, 1024, Kp, (const bf16*)(ws + (l == 0 ? WS_WO : WS_WSGOUT)), F.G, (int)blockIdx.x);
          pg8::EpiRes<l == 0> E{l == 0 ? (const void*)kin(0) : (const void*)XB, XB, modl + 2 * 1024};

#if PHMASK & 128
          pg8::gemm_phase<pg8::EpiRes<l == 0>, pg8::ProbDense, true>(F.lds, A0, Kp, S, E);
#endif
        }
        GRID_BAR();
#if PHMASK & 256
        phase_norm_router(F, XB, kin(4) + l * 1024, modl, (const bf16*)(ws + WS_WRP) + (size_t)l * 8 * 2 * 64 * 1024, (const float*)(ws + WS_RC) + l * 512, kin(21) + l * 64, A0, a_e, a_pos, a_w, ctl + CW_CNT + 64 * l);
#endif
        GRID_BAR();
#if PHMASK & 512
        for (int rep = 0; rep < REP_DISP; ++rep) phase_dispatch(F, ctl + CW_CNT + 64 * l, a_e, a_pos, a_w, tok_of_slot, w_of_slot, slot_of, tile_e);
#endif
        GRID_BAR();
        int ntr = ld_agent(tile_e + 2048); ntr = ntr < 0 ? 0 : (ntr > MAXRT ? MAXRT : ntr);
        const int xcd_ = F.vcu >> 5, idx_ = F.vcu & 31; const bool split_ = (l == 0) && (F.G == 256);
        const bool conv_ = split_ && idx_ >= 30 && xcd_ < 6;
        if (conv_) convert_moe_weights(F, 1, (bf16*)(ws + WS_WGU), 0, CV_SPLIT, ((xcd_ * 2 + (idx_ - 30)) * NWAVES + F.wave), 12 * NWAVES);
        else
        { ProbGU S{256 + ntr, split_ ? 244 : F.G, split_ ? F.vcu - 2 * (xcd_ < 6 ? xcd_ : 6) : F.vcu, tok_of_slot, tile_e, (const bf16*)(l == 0 ? (unsigned char*)kout() + CV_OUT_OFF : ws + WS_WGU)};
          pg8::EpiGU E{HM, w_of_slot};

#if PHMASK & 1024
          for (int rep = 0; rep < REP_GU; ++rep) pg8::gemm_phase<pg8::EpiGU, ProbGU, true>(F.lds, A0, 1024, S, E);
#endif
        }
        GRID_BAR();
        { ProbDown S{256 + ntr, F.G, F.vcu, tile_e, (const bf16*)(l == 0 ? (unsigned char*)kout() + CV_OUT_OFF + (WS_WD - WS_WGU) : ws + WS_WD)};
          pg8::EpiDown E{(unsigned char*)Yb};
#if PHMASK & 4096
          for (int rep = 0; rep < REP_DOWN; ++rep) pg8::gemm_phase<pg8::EpiDown, ProbDown, true>(F.lds, HM, 256, S, E);
#endif
        }
        GRID_BAR();
#if PHMASK & 8192
        phase_combine(F, l, (const unsigned char*)Yb, slot_of, XB, A0, kout());
        if (l == 0) convert_moe_weights(F, 1, (bf16*)(ws + WS_WGU), CV_SPLIT, CV_NITEMS, F.vcu * NWAVES + F.wave, F.G * NWAVES);
#endif
        GRID_BAR();
}

__global__ void __launch_bounds__(NWAVES * 64, 2) fwd(Args a) {
    extern __shared__ __attribute__((aligned(16))) unsigned char lds[];
    Frame F;
    F.lds = (LAS unsigned char*)lds;
    F.wave = __builtin_amdgcn_readfirstlane((int)threadIdx.x >> 6);
    F.G = gridDim.x; { const int bx = blockIdx.x; F.vcu = (F.G % 8 == 0) ? (bx % 8) * (F.G / 8) + bx / 8 : bx; }
    gu32* ctl = (gu32*)(ws + WS_CTL);
    for (int u = threadIdx.x; u < (LDS_BYTES - LDSCTL_OFF) / 4; u += NWAVES * 64) ((LAS unsigned*)(F.lds + LDSCTL_OFF))[u] = 0u;
    __syncthreads();
    volatile LAS unsigned* MISC = (volatile LAS unsigned*)(F.lds + MISC_OFF);
    (void)xcd_barrier_post((unsigned*)(ctl + CW_BAR), MISC + 8);


#if PHMASK & 1
    for (int rep = 0; rep < REP_PRO; ++rep) phase_prologue(F, a);
#endif
    GRID_BAR();
#if PHMASK & 2
    router_precompute(F);
    for (int rep = 0; rep < REP_NORM1; ++rep) phase_norm(F, kin(0), kin(3), mod, mod + 1024, A0);
#endif
    GRID_BAR();

    layer_body<0>(F, a, (char*)lds);
    layer_body<1>(F, a, (char*)lds);
}
#undef ws
#undef mod
#undef modl
#undef A0
#undef XB
#undef Qb
#undef Kb
#undef Vb
#undef OS
#undef HM
#undef Yb
#undef Zb
#undef a_e
#undef a_pos
#undef a_w
#undef tok_of_slot
#undef w_of_slot
#undef slot_of
#undef tile_e

extern "C" void kernel_launch(void* const* d_in, const int* in_sizes, int n_in, void* d_out, int out_size, void* d_ws, size_t ws_size, hipStream_t stream) {
    static int grid = 0;
    if (grid == 0) {
        if (n_in != 29 || out_size != T * D || ws_size < WS_END) { fprintf(stderr, "kernel_launch: unexpected shapes: n_in %d out %d ws %zu (need %zu)\n", n_in, out_size, ws_size, (size_t)WS_END); grid = -1; return; }
        int dev = 0, cus = 0, per_cu = 0;
        if (hipGetDevice(&dev) != hipSuccess || hipDeviceGetAttribute(&cus, hipDeviceAttributeMultiprocessorCount, dev) != hipSuccess) { grid = -1; return; }
        if (hipFuncSetAttribute((const void*)fwd, hipFuncAttributeMaxDynamicSharedMemorySize, LDS_BYTES) != hipSuccess) { fprintf(stderr, "kernel_launch: hipFuncSetAttribute failed\n"); grid = -1; return; }
        if (hipOccupancyMaxActiveBlocksPerMultiprocessor(&per_cu, (const void*)fwd, NWAVES * 64, LDS_BYTES) != hipSuccess || per_cu < 1)
            fprintf(stderr, "kernel_launch: note: occupancy query reports %d workgroups per CU\n", per_cu);
        (void)hipGetLastError();
        grid = cus;
    }
    if (grid < 0) return;
    if (hipMemsetAsync((char*)d_ws + WS_CTL, 0, CTL_ZERO_BYTES, stream) != hipSuccess) return;
    Args a{};
    for (int i = 0; i < 29; ++i) a.in[i] = (const float*)d_in[i];
    a.out = (float*)d_out; a.ws = (unsigned char*)d_ws;
    hipLaunchKernelGGL(fwd, dim3(grid), dim3(NWAVES * 64), LDS_BYTES, stream, a);
    const hipError_t le = hipPeekAtLastError();
    if (le != hipSuccess) fprintf(stderr, "kernel_launch: launch failed: %s\n", hipGetErrorName(le));
}
```

```cpp
#include <hip/hip_runtime.h>
#include <cstdio>
#include <cstdint>

constexpr int BATCH = 8, SEQ = 8192, T = BATCH * SEQ, D = 1024;
constexpr int NE = 64, TOPK = 6;
constexpr int TK = T * TOPK;
constexpr int MAXRT = 1600;
constexpr float EPS = 1e-6f;
constexpr int NWAVES = 8;
#define REP_PRO 1
#define REP_NORM1 1
#define REP_QKV 1
#define REP_ATT 1
#define REP_DIFF 1
#define REP_SGIN 1
#define REP_SPAT 1
#define REP_DISP 1
#define REP_GU 1
#define REP_DOWN 1
#ifndef PHMASK
#define PHMASK 0xFFFF
#endif

__device__ __forceinline__ int opq(int x) { asm volatile("" : "+v"(x)); return x; }

namespace pg8 {
#define PG8_LAS __attribute__((address_space(3)))
typedef unsigned short bf16_t;
typedef short bf16x8 __attribute__((ext_vector_type(8)));
typedef float f32x4 __attribute__((ext_vector_type(4)));
typedef float f32x2 __attribute__((ext_vector_type(2)));
typedef unsigned u32x4 __attribute__((ext_vector_type(4)));
constexpr int BM = 256, BK = 64, HALF = 128, HTB = HALF * BK * 2, STAGE_BYTES = 8 * HTB, NXCD = 8, WGM = 8;

__host__ __device__ __forceinline__ int lds_byte(int r, int c) { const int st = (r >> 4) * 2 + (c >> 5), rr = r & 15, cc = c & 31, ob = rr * 64 + cc * 2; return st * 1024 + (ob ^ (((ob >> 9) & 1) << 5)); }
__host__ __device__ __forceinline__ void stage_rc(int b, int& R, int& C) { const int st = b / 1024, sb = b % 1024, swz = sb ^ (((sb >> 9) & 1) << 5); R = (st >> 1) * 16 + swz / 64; C = (st & 1) * 32 + (swz % 64) / 2; }
__host__ __device__ __forceinline__ int perm32(int rho) { const int n = rho >> 4, i = rho & 15; return 8 * (i >> 2) + 4 * n + (i & 3); }

struct Unit { int pm, pn; };

__device__ __forceinline__ unsigned cvt_pk_bf16(float lo, float hi) { unsigned r; asm volatile("v_cvt_pk_bf16_f32 %0, %1, %2" : "=v"(r) : "v"(lo), "v"(hi)); return r; }
__device__ __forceinline__ f32x2 gelu_pk(f32x2 v) {
    const f32x2 av = __builtin_elementwise_abs(v), d = av * 0.2316418882f + 1.0f;
    f32x2 t; t.x = __builtin_amdgcn_rcpf(d.x); t.y = __builtin_amdgcn_rcpf(d.y);
    f32x2 q = t * 0.5307027145f + (-0.7265760135f); q = q * t + 0.7107068705f; q = q * t + (-0.142248368f); q = q * t + 0.127414796f; q = q * t;
    const f32x2 s = (v * v) * (-0.72134752044f);
    f32x2 e; e.x = __builtin_amdgcn_exp2f(s.x); e.y = __builtin_amdgcn_exp2f(s.y);
    const f32x2 m = v * (q * e), r = v - m;
    f32x2 o; o.x = v.x < 0.f ? m.x : r.x; o.y = v.y < 0.f ? m.y : r.y; return o;
}

struct ProbDense {
    static constexpr bool GATHER = false;
    int nM, nN, nwg, G, c; const bf16_t* Bt; int K;
    __device__ __forceinline__ void init(int M, int N, int K_, const bf16_t* Bt_, int G_, int c_) { nM = M / BM; nN = N / BM; nwg = nM * nN; G = G_; c = c_; Bt = Bt_; K = K_; }
    __device__ __forceinline__ bool next(int i, Unit& u) const {
        const long L = (long)i * G + c; if (L >= nwg) return false;
        int wgid = (int)L; { const int q = nwg / NXCD, r = nwg % NXCD, xcd = wgid % NXCD, off = wgid / NXCD; wgid = (xcd < r ? xcd * (q + 1) : r * (q + 1) + (xcd - r) * q) + off; }
        const int nig = WGM * nN, gid = wgid / nig, fm = gid * WGM, gsz = (nM - fm) < WGM ? (nM - fm) : WGM;
        u.pm = fm + ((wgid % nig) % gsz); u.pn = (wgid % nig) / gsz; return true;
    }
    __device__ __forceinline__ const char* bbase(const Unit& u) const { return (const char*)Bt + (size_t)u.pn * BM * K * 2; }
    __device__ __forceinline__ size_t abase(const Unit& u) const { return (size_t)u.pm * BM * K * 2; }
    __device__ __forceinline__ unsigned arow(const Unit& u, int r) const { return (unsigned)(u.pm * BM + r); }
};

template <int ACT> struct EpiBf16 {
    static constexpr bool PERM = true; static constexpr bool PERM16 = false;
    bf16_t* O; int ldc;
    __device__ __forceinline__ void operator()(const f32x4 (&acc)[2][2][4][2], const Unit& u, int wr, int wc, int fr, int fq) const {
        const int row0 = u.pm * BM + wr * 64 + fr, col0 = u.pn * BM + wc * 32 + 8 * fq;
#pragma unroll
        for (int ai = 0; ai < 2; ++ai)
#pragma unroll
            for (int m = 0; m < 4; ++m) { bf16_t* rowp = O + (size_t)(row0 + ai * HALF + m * 16) * ldc + col0;
#pragma unroll
                for (int bj = 0; bj < 2; ++bj) { f32x4 v0 = acc[ai][bj][m][0], v1 = acc[ai][bj][m][1];
                    if (ACT == 1) { f32x2 a = gelu_pk((f32x2){v0[0], v0[1]}), b = gelu_pk((f32x2){v0[2], v0[3]}), c = gelu_pk((f32x2){v1[0], v1[1]}), d = gelu_pk((f32x2){v1[2], v1[3]});
                        v0 = (f32x4){a.x, a.y, b.x, b.y}; v1 = (f32x4){c.x, c.y, d.x, d.y}; }
                    u32x4 w; w.x = cvt_pk_bf16(v0[0], v0[1]); w.y = cvt_pk_bf16(v0[2], v0[3]); w.z = cvt_pk_bf16(v1[0], v1[1]); w.w = cvt_pk_bf16(v1[2], v1[3]);
                    *(u32x4*)(rowp + bj * HALF) = w; } }
    }
};
struct EpiQKV {
    static constexpr bool PERM = true; static constexpr bool PERM16 = false;
    bf16_t* Q; size_t sec_stride; const float* cosT; const float* sinT; float qscale;
    __device__ __forceinline__ void operator()(const f32x4 (&acc)[2][2][4][2], const Unit& u, int wr, int wc, int fr, int fq) const {
        const int colt = u.pn * BM, sec = colt >> 10, cin = colt & 1023;
        bf16_t* base = Q + (size_t)sec * sec_stride;
        const int row0 = u.pm * BM + wr * 64 + fr, col0 = cin + wc * 32 + 8 * fq, g = 4 * (wc & 1) + fq;
        const float qs = sec == 0 ? qscale : 1.0f;
#pragma unroll
        for (int ai = 0; ai < 2; ++ai)
#pragma unroll
            for (int m = 0; m < 4; ++m) { const int row = row0 + ai * HALF + m * 16; bf16_t* rowp = base + (size_t)row * 1024 + col0;
                f32x4 c4 = (f32x4){1.f, 1.f, 1.f, 1.f}, s4 = (f32x4){0.f, 0.f, 0.f, 0.f};
                if (sec < 2) { c4 = *(const f32x4*)(cosT + (size_t)row * 32 + 4 * g); s4 = *(const f32x4*)(sinT + (size_t)row * 32 + 4 * g); }
#pragma unroll
                for (int bj = 0; bj < 2; ++bj) { const f32x4 x1 = acc[ai][bj][m][0], x2 = acc[ai][bj][m][1];
                    const f32x4 v0 = (x1 * c4 - x2 * s4) * qs, v1 = (x2 * c4 + x1 * s4) * qs;
                    u32x4 w; w.x = cvt_pk_bf16(v0[0], v0[1]); w.y = cvt_pk_bf16(v0[2], v0[3]); w.z = cvt_pk_bf16(v1[0], v1[1]); w.w = cvt_pk_bf16(v1[2], v1[3]);
                    *(u32x4*)(rowp + bj * HALF) = w; } }
    }
};
template <bool BASE_F32> struct EpiRes {
    static constexpr bool PERM = true; static constexpr bool PERM16 = false;
    const void* base; bf16_t* out; const float* gate;
    __device__ __forceinline__ void operator()(const f32x4 (&acc)[2][2][4][2], const Unit& u, int wr, int wc, int fr, int fq) const {
        const int b = (u.pm * BM) / SEQ; const float* gp = gate + (size_t)b * 6144;
        const int col0 = u.pn * BM + wc * 32 + 8 * fq;
        f32x4 gv[2][2];
#pragma unroll
        for (int bj = 0; bj < 2; ++bj)
#pragma unroll
            for (int n = 0; n < 2; ++n) gv[bj][n] = *(const f32x4*)(gp + col0 + bj * HALF + n * 4);
#pragma unroll
        for (int ai = 0; ai < 2; ++ai)
#pragma unroll
            for (int m = 0; m < 4; ++m) { const size_t off = (size_t)(u.pm * BM + ai * HALF + wr * 64 + m * 16 + fr) * 1024 + col0;
#pragma unroll
                for (int bj = 0; bj < 2; ++bj) { f32x4 b0, b1;
                    if constexpr (BASE_F32) { b0 = *(const f32x4*)((const float*)base + off + bj * HALF); b1 = *(const f32x4*)((const float*)base + off + bj * HALF + 4); }
                    else { const u32x4 w = *(const u32x4*)((const bf16_t*)base + off + bj * HALF);
                        b0 = (f32x4){__uint_as_float(w.x << 16), __uint_as_float(w.x & 0xffff0000u), __uint_as_float(w.y << 16), __uint_as_float(w.y & 0xffff0000u)};
                        b1 = (f32x4){__uint_as_float(w.z << 16), __uint_as_float(w.z & 0xffff0000u), __uint_as_float(w.w << 16), __uint_as_float(w.w & 0xffff0000u)}; }
                    const f32x4 o0 = b0 + gv[bj][0] * acc[ai][bj][m][0], o1 = b1 + gv[bj][1] * acc[ai][bj][m][1];
                    u32x4 ow; ow.x = cvt_pk_bf16(o0[0], o0[1]); ow.y = cvt_pk_bf16(o0[2], o0[3]); ow.z = cvt_pk_bf16(o1[0], o1[1]); ow.w = cvt_pk_bf16(o1[2], o1[3]);
                    *(u32x4*)(out + off + bj * HALF) = ow; } }
    }
};
struct EpiGU {
    static constexpr bool PERM = true; static constexpr bool PERM16 = false;
    bf16_t* H; const float* wslot;
    __device__ __forceinline__ void operator()(const f32x4 (&acc)[2][2][4][2], const Unit& u, int wr, int wc, int fr, int fq) const {
        const int row0 = u.pm * BM + wr * 64 + fr, col0 = u.pn * 128 + wc * 32 + 8 * fq;
        float wv[2][4];
#pragma unroll
        for (int ai = 0; ai < 2; ++ai)
#pragma unroll
            for (int m = 0; m < 4; ++m) wv[ai][m] = wslot[row0 + ai * HALF + m * 16];
#pragma unroll
        for (int ai = 0; ai < 2; ++ai)
#pragma unroll
            for (int m = 0; m < 4; ++m) { bf16_t* rowp = H + (size_t)(row0 + ai * HALF + m * 16) * 256 + col0;
                float h[8];
#pragma unroll
                for (int n = 0; n < 2; ++n)
#pragma unroll
                    for (int j = 0; j < 4; ++j) { const float gt = acc[ai][0][m][n][j], up = acc[ai][1][m][n][j];
                        h[n * 4 + j] = gt * __builtin_amdgcn_rcpf(1.0f + __builtin_amdgcn_exp2f(-1.4426950408889634f * gt)) * (up * wv[ai][m]); }
                u32x4 w; w.x = cvt_pk_bf16(h[0], h[1]); w.y = cvt_pk_bf16(h[2], h[3]); w.z = cvt_pk_bf16(h[4], h[5]); w.w = cvt_pk_bf16(h[6], h[7]);
                *(u32x4*)rowp = w; }
    }
};
struct EpiDown {
    static constexpr bool PERM = true; static constexpr bool PERM16 = true;
    unsigned char* Y;
    __device__ __forceinline__ void operator()(const f32x4 (&acc)[2][2][4][2], const Unit& u, int wr, int wc, int fr, int fq) const {
        const int row0 = u.pm * BM + wr * 64 + fr, col0 = u.pn * BM + wc * 64 + 16 * fq;
#pragma unroll
        for (int ai = 0; ai < 2; ++ai)
#pragma unroll
            for (int m = 0; m < 4; ++m) { unsigned char* rowp = Y + (size_t)(row0 + ai * HALF + m * 16) * 1024 + col0;
                u32x4 w;
#pragma unroll
                for (int bj = 0; bj < 2; ++bj)
#pragma unroll
                    for (int n = 0; n < 2; ++n) { f32x4 v = acc[ai][bj][m][n] * 16.0f;
#pragma unroll
                        for (int j = 0; j < 4; ++j) v[j] = __builtin_fminf(__builtin_fmaxf(v[j], -440.f), 440.f);
                        int q = __builtin_amdgcn_cvt_pk_fp8_f32(v[0], v[1], 0, false); q = __builtin_amdgcn_cvt_pk_fp8_f32(v[2], v[3], q, true);
                        w[2 * bj + n] = (unsigned)q; }
                *(u32x4*)rowp = w; }
    }
};

template <class Epi, class Prob, bool ALIGN_EPI>
__device__ __forceinline__ void gemm_phase(PG8_LAS unsigned char* lds, const bf16_t* Aglob, const int K, const Prob& S, const Epi& E) {
    const int tid = opq(threadIdx.x), wid = __builtin_amdgcn_readfirstlane(tid >> 6), lane = tid & 63, wr = wid >> 2, wc = wid & 3, fr = lane & 15, fq = lane >> 4;
    const int nt = K / BK;
    int Rr[2]; unsigned cA2[2], voffA[2], voffB[2];
#pragma unroll
    for (int i = 0; i < 2; ++i) { int R, C; stage_rc(tid * 16 + i * 8192, R, C); const int Rb = Epi::PERM16 ? (64 * (R >> 5) + 16 * ((R & 15) >> 2) + 4 * ((R >> 4) & 1) + (R & 3)) : (Epi::PERM ? ((R & ~31) + perm32(R & 31)) : R);
        Rr[i] = R; cA2[i] = (unsigned)C * 2u; voffA[i] = (unsigned)(R * K + C) * 2u; voffB[i] = (unsigned)(Rb * K + C) * 2u; }
    const unsigned rowbytes = (unsigned)K * 2u;
    const size_t kstep = (size_t)(BK * 2);
    const size_t hstep = (size_t)HALF * K * 2;
    const size_t hstepB = Epi::PERM16 ? (size_t)8 * K * 2 : hstep;
    const unsigned ldsw = (unsigned)wid * 1024u;
    const int aoff = lds_byte(wr * 64 + fr, fq * 8), boff = lds_byte(wc * 32 + fr, fq * 8);
#define PG8_SA(b, h) (((b) * 2 + (h)) * HTB)
#define PG8_SB(b, h) ((4 + (b) * 2 + (h)) * HTB)
#define PG8_STAGE(bufoff, gbase, voff) do { _Pragma("unroll") for (int _i = 0; _i < 2; ++_i) \
        __builtin_amdgcn_global_load_lds((const unsigned*)((const char*)(gbase) + (voff)[_i]), (PG8_LAS unsigned*)(lds + (bufoff) + ldsw + _i * 8192), 16, 0, 0); } while (0)
#define PG8_STAGE_A(bufoff, koff, h, NXT) do { if constexpr (Prob::GATHER) { PG8_STAGE(bufoff, Ab + (koff), (NXT) ? v2[h] : vAc[h]); } \
        else { PG8_STAGE(bufoff, ((NXT) ? a2u : cA) + (koff) + (h) * hstep, voffA); } } while (0)
#define PG8_LDA(dst, b, h) do { _Pragma("unroll") for (int m = 0; m < 4; ++m) _Pragma("unroll") for (int k = 0; k < 2; ++k) dst[m][k] = *(const PG8_LAS bf16x8*)(lds + PG8_SA(b, h) + aoff + m * 2048 + k * 1024); } while (0)
#define PG8_LDB(dst, b, h) do { _Pragma("unroll") for (int n = 0; n < 2; ++n) _Pragma("unroll") for (int k = 0; k < 2; ++k) dst[n][k] = *(const PG8_LAS bf16x8*)(lds + PG8_SB(b, h) + boff + n * 2048 + k * 1024); } while (0)
#define PG8_MMA(ai, bj, At, Bt) do { __builtin_amdgcn_s_setprio(1); _Pragma("unroll") for (int m = 0; m < 4; ++m) _Pragma("unroll") for (int n = 0; n < 2; ++n) _Pragma("unroll") for (int k = 0; k < 2; ++k) \
        acc[ai][bj][m][n] = __builtin_amdgcn_mfma_f32_16x16x32_bf16(Bt[n][k], At[m][k], acc[ai][bj][m][n], 0, 0, 0); __builtin_amdgcn_s_setprio(0); } while (0)
#define PG8_WAIT_V(n) asm volatile("s_waitcnt vmcnt(" #n ")" ::: "memory")
#define PG8_WAIT_L(n) asm volatile("s_waitcnt lgkmcnt(" #n ")" ::: "memory")
#define PG8_BAR __builtin_amdgcn_s_barrier()
#define PG8_SCHED __builtin_amdgcn_sched_barrier(0)
    Unit cur, nxt; int ui = 0;
    if (!S.next(0, cur)) return;
    f32x4 acc[2][2][4][2];
#pragma unroll
    for (int a = 0; a < 2; ++a)
#pragma unroll
        for (int b = 0; b < 2; ++b)
#pragma unroll
            for (int m = 0; m < 4; ++m)
#pragma unroll
                for (int n = 0; n < 2; ++n) acc[a][b][m][n] = (f32x4){0.f, 0.f, 0.f, 0.f};
    bf16x8 At[4][2], B0[2][2], B1[2][2];
    unsigned vAc[2][2], vAn[2][2], v2[2][2];
    const char* Ab = (const char*)Aglob; const char* cB = S.bbase(cur);
    const char* cA = Ab; const char* a2u = Ab;
    if constexpr (Prob::GATHER) {
#pragma unroll
        for (int h = 0; h < 2; ++h)
#pragma unroll
            for (int i = 0; i < 2; ++i) { vAc[h][i] = S.arow(cur, h * HALF + Rr[i]) * rowbytes + cA2[i]; v2[h][i] = vAc[h][i]; vAn[h][i] = vAc[h][i]; }
    } else { cA = Ab + S.abase(cur); a2u = cA; }
    PG8_STAGE(PG8_SB(0, 0), cB, voffB); PG8_STAGE(PG8_SB(0, 1), cB + hstepB, voffB); PG8_STAGE_A(PG8_SA(0, 0), 0, 0, false); PG8_STAGE_A(PG8_SA(0, 1), 0, 1, false);
    if (wr == 1) PG8_BAR;
    PG8_WAIT_V(2); PG8_BAR;
    PG8_STAGE(PG8_SB(1, 0), cB + kstep, voffB); PG8_STAGE_A(PG8_SA(1, 0), kstep, 0, false); PG8_STAGE(PG8_SB(1, 1), cB + hstepB + kstep, voffB);
    PG8_WAIT_V(6); PG8_BAR;
#pragma unroll 1
    for (;;) {
        const bool has_next = S.next(ui + 1, nxt);
        const Unit nn = has_next ? nxt : cur;
        const char* nB = S.bbase(nn);
        const char* nA = Ab;
        if constexpr (Prob::GATHER) {
#pragma unroll
            for (int h = 0; h < 2; ++h)
#pragma unroll
                for (int i = 0; i < 2; ++i) vAn[h][i] = S.arow(nn, h * HALF + Rr[i]);
        } else nA = Ab + S.abase(nn);
#pragma unroll 1
        for (int t = 0; t < nt; t += 2) {
            const bool last = (t == nt - 2);
            const size_t k1 = (size_t)(t + 1) * kstep;
            const size_t k2 = last ? 0 : (size_t)(t + 2) * kstep, k3 = k2 + kstep;
            const char* b2 = last ? nB : cB + (size_t)(t + 2) * kstep; const char* b3 = b2 + kstep;
            if constexpr (Prob::GATHER) {
                if (last) {
#pragma unroll
                    for (int h = 0; h < 2; ++h)
#pragma unroll
                        for (int i = 0; i < 2; ++i) { asm volatile("" : "+v"(vAn[h][i])); vAn[h][i] = vAn[h][i] * rowbytes + cA2[i]; }
                }
#pragma unroll
                for (int h = 0; h < 2; ++h)
#pragma unroll
                    for (int i = 0; i < 2; ++i) v2[h][i] = last ? vAn[h][i] : vAc[h][i];
            } else a2u = last ? nA : cA;
            PG8_LDB(B0, 0, 0); PG8_LDB(B1, 0, 1); PG8_SCHED; PG8_LDA(At, 0, 0); PG8_STAGE_A(PG8_SA(1, 1), k1, 1, false);
            PG8_WAIT_V(8); PG8_WAIT_L(0); PG8_BAR; PG8_MMA(0, 0, At, B0); PG8_MMA(0, 1, At, B1); PG8_BAR; PG8_SCHED;
            PG8_LDA(At, 0, 1); PG8_STAGE(PG8_SB(0, 0), b2, voffB); PG8_STAGE(PG8_SB(0, 1), b2 + hstepB, voffB); PG8_STAGE_A(PG8_SA(0, 0), k2, 0, true);
            PG8_WAIT_V(8); PG8_WAIT_L(0); PG8_BAR; PG8_MMA(1, 0, At, B0); PG8_MMA(1, 1, At, B1); PG8_BAR; PG8_SCHED;
            PG8_LDB(B0, 1, 0); PG8_LDB(B1, 1, 1); PG8_SCHED; PG8_LDA(At, 1, 0); PG8_STAGE_A(PG8_SA(0, 1), k2, 1, true);
            PG8_WAIT_V(8); PG8_WAIT_L(0); PG8_BAR; PG8_MMA(0, 0, At, B0); PG8_MMA(0, 1, At, B1); PG8_BAR; PG8_SCHED;
            PG8_LDA(At, 1, 1); PG8_STAGE(PG8_SB(1, 0), b3, voffB); PG8_STAGE(PG8_SB(1, 1), b3 + hstepB, voffB); PG8_STAGE_A(PG8_SA(1, 0), k3, 0, true);
            PG8_WAIT_V(8); PG8_WAIT_L(0); PG8_BAR; PG8_MMA(1, 0, At, B0); PG8_MMA(1, 1, At, B1); PG8_BAR; PG8_SCHED;
        }
        if constexpr (ALIGN_EPI) { if (wr == 0) PG8_BAR; }
        E(acc, cur, wr, wc, fr, fq);
        if (!has_next) break;
#pragma unroll
        for (int a = 0; a < 2; ++a)
#pragma unroll
            for (int b = 0; b < 2; ++b)
#pragma unroll
                for (int m = 0; m < 4; ++m)
#pragma unroll
                    for (int n = 0; n < 2; ++n) acc[a][b][m][n] = (f32x4){0.f, 0.f, 0.f, 0.f};
        cur = nxt; cB = nB; cA = nA; ++ui;
        if constexpr (Prob::GATHER) {
#pragma unroll
            for (int h = 0; h < 2; ++h)
#pragma unroll
                for (int i = 0; i < 2; ++i) vAc[h][i] = vAn[h][i];
        }
        if constexpr (ALIGN_EPI) { if (wr == 1) PG8_BAR; }
    }
    PG8_WAIT_V(0);
    if constexpr (!ALIGN_EPI) { if (wr == 0) PG8_BAR; }
    PG8_BAR;
#undef PG8_SA
#undef PG8_SB
#undef PG8_STAGE
#undef PG8_STAGE_A
#undef PG8_LDA
#undef PG8_LDB
#undef PG8_MMA
#undef PG8_WAIT_V
#undef PG8_WAIT_L
#undef PG8_BAR
#undef PG8_SCHED
}
}

namespace att {
typedef unsigned short bf16_t;
using bf16x8 = __attribute__((ext_vector_type(8))) short;
using s16x4  = __attribute__((ext_vector_type(4))) short;
using f32x16 = __attribute__((ext_vector_type(16))) float;
using u32x4  = __attribute__((ext_vector_type(4))) unsigned;
constexpr int NW = 8, QBLK = 32, KVBLK = 64;
constexpr float QSCALE = 0.125f * 1.4426950408889634f;
constexpr float THRL = 11.5f;
constexpr int LDQ = 1024, LDK = 1024, LDV = 1024, LDO = 2048;
constexpr size_t SHM_V = KVBLK * 128 * 2, SHM_K = KVBLK * 64 * 2, SHM_ATTN = 3 * SHM_V + 3 * SHM_K;
#define KSWZ(row, colB) ((row) * 128 + ((colB) ^ ((((row) >> 1) & 7) << 4)))
#define SBAR() __builtin_amdgcn_sched_barrier(0)
__device__ __forceinline__ int crow(int r, int hi) { return (r & 3) + 8 * (r >> 2) + 4 * hi; }
__device__ __forceinline__ unsigned cvtpk(float lo, float hi) { unsigned r; asm volatile("v_cvt_pk_bf16_f32 %0, %1, %2" : "=v"(r) : "v"(lo), "v"(hi)); return r; }

template <bool FIRST> __device__ __forceinline__ void partialSM(f32x16& p0, f32x16& p1, float& mhat, f32x16& negm, float& alpha) {
  float ma = fmaxf(p0[0], p0[1]), mb = fmaxf(p0[2], p0[3]), mc = fmaxf(p1[0], p1[1]), md = fmaxf(p1[2], p1[3]);
#pragma unroll
  for (int r = 4; r < 16; r += 4) { ma = fmaxf(fmaxf(ma, p0[r]), p0[r + 1]); mb = fmaxf(fmaxf(mb, p0[r + 2]), p0[r + 3]); mc = fmaxf(fmaxf(mc, p1[r]), p1[r + 1]); md = fmaxf(fmaxf(md, p1[r + 2]), p1[r + 3]); }
  const float pmaxh = fmaxf(fmaxf(ma, mb), fmaxf(mc, md));
  alpha = 1.f;
  if (FIRST || !__builtin_expect(__all(pmaxh <= THRL), 1)) {
    float pmax; { auto rr = __builtin_amdgcn_permlane32_swap(__float_as_uint(pmaxh), __float_as_uint(pmaxh), false, false);
      pmax = fmaxf(__uint_as_float(rr[0]), __uint_as_float(rr[1])); }
    const float dl = FIRST ? pmax : fmaxf(pmax, 0.f);
    mhat += dl; if (!FIRST) alpha = __builtin_amdgcn_exp2f(-dl);
#pragma unroll
    for (int r = 0; r < 16; ++r) { p0[r] -= dl; p1[r] -= dl; }
#pragma unroll
    for (int r = 0; r < 16; ++r) negm[r] = -mhat;
    asm volatile("" : "+v"(negm));
  }
#pragma unroll
  for (int r = 0; r < 16; ++r) p0[r] = __builtin_amdgcn_exp2f(p0[r]);
}
__device__ __forceinline__ void finishSM(f32x16& p0, f32x16& p1, float alpha, float& l_reg, bf16x8& pb0, bf16x8& pb1, bf16x8& pb2, bf16x8& pb3) {
#pragma unroll
  for (int r = 0; r < 16; ++r) p1[r] = __builtin_amdgcn_exp2f(p1[r]);
  float ps = 0;
#pragma unroll
  for (int r = 0; r < 16; ++r) ps += p0[r];
#pragma unroll
  for (int r = 0; r < 16; ++r) ps += p1[r];
  { auto rr = __builtin_amdgcn_permlane32_swap(__float_as_uint(ps), __float_as_uint(ps), false, false);
    ps = __uint_as_float(rr[0]) + __uint_as_float(rr[1]); }
  l_reg = l_reg * alpha + ps;
#define PK8(P, BASE, OUT) do { u32x4 w = {cvtpk(P[BASE + 0], P[BASE + 1]), cvtpk(P[BASE + 2], P[BASE + 3]), cvtpk(P[BASE + 4], P[BASE + 5]), cvtpk(P[BASE + 6], P[BASE + 7])}; OUT = *reinterpret_cast<bf16x8*>(&w); } while (0)
  PK8(p0, 0, pb0); PK8(p0, 8, pb1); PK8(p1, 0, pb2); PK8(p1, 8, pb3);
#undef PK8
}
__device__ __forceinline__ void qkt(f32x16& p0, f32x16& p1, const char* Ks, const bf16x8* qr, const f32x16& negm, int r32, int hi) {
#pragma unroll
  for (int d0 = 0; d0 < 4; ++d0) { const int cb = (d0 * 16 + hi * 8) * 2;
    bf16x8 b0 = *reinterpret_cast<const bf16x8*>(Ks + KSWZ(r32, cb));
    bf16x8 b1 = *reinterpret_cast<const bf16x8*>(Ks + KSWZ(32 + r32, cb));
    if (d0 == 0) { p0 = __builtin_amdgcn_mfma_f32_32x32x16_bf16(b0, qr[0], negm, 0, 0, 0); p1 = __builtin_amdgcn_mfma_f32_32x32x16_bf16(b1, qr[0], negm, 0, 0, 0); }
    else { p0 = __builtin_amdgcn_mfma_f32_32x32x16_bf16(b0, qr[d0], p0, 0, 0, 0); p1 = __builtin_amdgcn_mfma_f32_32x32x16_bf16(b1, qr[d0], p1, 0, 0, 0); } }
}
__device__ __forceinline__ int v_st(int k, int c) { const int kk = (k & ~0xC) | ((k & 4) << 1) | ((k & 8) >> 1); return ((kk >> 3) * 4 + (c >> 5)) * 512 + ((kk & 7) * 32 + (c & 31)) * 2; }
__device__ __forceinline__ int v_st_n(int k, int c) { return ((k >> 3) * 4 + (c >> 5)) * 512 + ((k & 7) * 32 + (c & 31)) * 2; }
__device__ __forceinline__ int v_rd_base(int lane) { return ((lane & 3) << 3) | (((lane >> 2) & 3) << 6) | (((lane >> 4) & 1) << 5) | (((lane >> 5) & 1) << 8); }
constexpr int v_rd_off(int d0, int ks, int half) { return d0 * 512 + ks * 4096 + half * 2048; }
template <int OFF> __device__ __forceinline__ s16x4 tr_read(int vb) {
  s16x4 r; asm volatile("ds_read_b64_tr_b16 %0, %1 offset:%2" : "=&v"(r) : "v"(vb), "i"(OFF) : "memory"); return r;
}
template <int D0> __device__ __forceinline__ void pv_one(f32x16& od, int vb, bf16x8 pa0, bf16x8 pa1, bf16x8 pa2, bf16x8 pa3) {
  const s16x4 l0 = tr_read<v_rd_off(D0, 0, 0)>(vb), h0 = tr_read<v_rd_off(D0, 0, 1)>(vb), l1 = tr_read<v_rd_off(D0, 1, 0)>(vb), h1 = tr_read<v_rd_off(D0, 1, 1)>(vb);
  const s16x4 l2 = tr_read<v_rd_off(D0, 2, 0)>(vb), h2 = tr_read<v_rd_off(D0, 2, 1)>(vb), l3 = tr_read<v_rd_off(D0, 3, 0)>(vb), h3 = tr_read<v_rd_off(D0, 3, 1)>(vb);
  asm volatile("s_waitcnt lgkmcnt(0)" ::: "memory"); SBAR();
#define PK(L, H) (bf16x8){L[0], L[1], L[2], L[3], H[0], H[1], H[2], H[3]}
  od = __builtin_amdgcn_mfma_f32_32x32x16_bf16(pa0, PK(l0, h0), od, 0, 0, 0);
  od = __builtin_amdgcn_mfma_f32_32x32x16_bf16(pa1, PK(l1, h1), od, 0, 0, 0);
  od = __builtin_amdgcn_mfma_f32_32x32x16_bf16(pa2, PK(l2, h2), od, 0, 0, 0);
  od = __builtin_amdgcn_mfma_f32_32x32x16_bf16(pa3, PK(l3, h3), od, 0, 0, 0);
#undef PK
}
__device__ __forceinline__ void pv_d0(f32x16* o, int vb, bf16x8 pa0, bf16x8 pa1, bf16x8 pa2, bf16x8 pa3) {
  pv_one<0>(o[0], vb, pa0, pa1, pa2, pa3); pv_one<1>(o[1], vb, pa0, pa1, pa2, pa3); pv_one<2>(o[2], vb, pa0, pa1, pa2, pa3); pv_one<3>(o[3], vb, pa0, pa1, pa2, pa3);
}
template <int D0> __device__ __forceinline__ void pvT_one(f32x16& od, int vb, bf16x8 pb0, bf16x8 pb1, bf16x8 pb2, bf16x8 pb3) {
  const s16x4 l0 = tr_read<v_rd_off(D0, 0, 0)>(vb), h0 = tr_read<v_rd_off(D0, 0, 1)>(vb), l1 = tr_read<v_rd_off(D0, 1, 0)>(vb), h1 = tr_read<v_rd_off(D0, 1, 1)>(vb);
  const s16x4 l2 = tr_read<v_rd_off(D0, 2, 0)>(vb), h2 = tr_read<v_rd_off(D0, 2, 1)>(vb), l3 = tr_read<v_rd_off(D0, 3, 0)>(vb), h3 = tr_read<v_rd_off(D0, 3, 1)>(vb);
  asm volatile("s_waitcnt lgkmcnt(0)" ::: "memory"); SBAR();
#define PK(L, H) (bf16x8){L[0], L[1], L[2], L[3], H[0], H[1], H[2], H[3]}
  od = __builtin_amdgcn_mfma_f32_32x32x16_bf16(PK(l0, h0), pb0, od, 0, 0, 0);
  od = __builtin_amdgcn_mfma_f32_32x32x16_bf16(PK(l1, h1), pb1, od, 0, 0, 0);
  od = __builtin_amdgcn_mfma_f32_32x32x16_bf16(PK(l2, h2), pb2, od, 0, 0, 0);
  od = __builtin_amdgcn_mfma_f32_32x32x16_bf16(PK(l3, h3), pb3, od, 0, 0, 0);
#undef PK
}
__device__ __forceinline__ void pvT(f32x16* o, int vb, bf16x8 pb0, bf16x8 pb1, bf16x8 pb2, bf16x8 pb3) {
  pvT_one<0>(o[0], vb, pb0, pb1, pb2, pb3); pvT_one<1>(o[1], vb, pb0, pb1, pb2, pb3); pvT_one<2>(o[2], vb, pb0, pb1, pb2, pb3); pvT_one<3>(o[3], vb, pb0, pb1, pb2, pb3);
}
__device__ __forceinline__ unsigned short f2bf1(float f) { unsigned u = __builtin_bit_cast(unsigned, f); return (unsigned short)((u + 0x7fffu + ((u >> 16) & 1u)) >> 16); }

__device__ __forceinline__ void attn_core(const bf16_t* __restrict__ Qb, const bf16_t* __restrict__ Kh, const bf16_t* __restrict__ Vh, int seq, char* lds, f32x16 (&o)[4]) {
  const int tid = opq(threadIdx.x), wid = tid >> 6, lane = tid & 63, r32 = lane & 31, hi = lane >> 5;
  char* K_lds = lds; char* V_lds = lds + 3 * SHM_K;
  float mhat = 0.f, l_reg = 0; bf16x8 qr[4]; f32x16 negm = {}; asm volatile("" : "+v"(negm));
#pragma unroll
  for (int d = 0; d < 4; ++d) o[d] = f32x16{};
  const bf16_t* Qw = Qb + (long)(wid * QBLK + r32) * LDQ + hi * 8;
#pragma unroll
  for (int d0 = 0; d0 < 4; ++d0) qr[d0] = *reinterpret_cast<const bf16x8*>(Qw + d0 * 16);
  const int vb0 = (int)(uintptr_t)V_lds + v_rd_base(lane);
  const int wu = __builtin_amdgcn_readfirstlane(wid);
  const int krow = 8 * wu + (lane >> 3); const unsigned goK = (unsigned)(krow * LDK + (((lane & 7) ^ ((krow >> 1) & 7)) * 8)) * 2u;
  unsigned goV[2];
#pragma unroll
  for (int i2 = 0; i2 < 2; ++i2) { const int st = 2 * (2 * wu + i2) + (lane >> 5), w = lane & 31; goV[i2] = (unsigned)((((st >> 2) * 8 + (w >> 2)) * LDV) + (st & 3) * 32 + (w & 3) * 8) * 2u; }
  const unsigned kl0 = (unsigned)(uintptr_t)K_lds + (unsigned)wu * 1024u, vl0 = (unsigned)(uintptr_t)V_lds + (unsigned)wu * 2048u;
#define DMA16(voff, gbase, laddr) asm volatile("s_mov_b32 m0, %2\n\ts_nop 0\n\tglobal_load_lds_dwordx4 %0, %1" :: "v"(voff), "s"(gbase), "s"(laddr) : "memory", "m0")
#define SLOAD(slot, k0) do { const bf16_t* kt_ = Kh + (size_t)(k0) * LDK; const bf16_t* vt_ = Vh + (size_t)(k0) * LDV; \
    DMA16(goK, kt_, kl0 + (unsigned)(slot) * (unsigned)SHM_K); DMA16(goV[0], vt_, vl0 + (unsigned)(slot) * (unsigned)SHM_V); DMA16(goV[1], vt_, vl0 + (unsigned)(slot) * (unsigned)SHM_V + 1024u); } while (0)
#define SWAIT() asm volatile("s_waitcnt vmcnt(0)" ::: "memory")
#define RESC(a) do { if (__any((a) < 1.f)) { _Pragma("unroll") for (int d = 0; d < 4; ++d) _Pragma("unroll") for (int r = 0; r < 16; ++r) o[d][r] *= (a); } } while (0)
#define ROT() do { const int n_ = sm; sm = s0; s0 = s1; s1 = n_; } while (0)
  f32x16 pA0, pA1, pB0, pB1; float alA, alB; bf16x8 pa0, pa1, pa2, pa3; const int NT = seq / KVBLK;
  SLOAD(0, 0); SWAIT(); __syncthreads();
  SLOAD(1, KVBLK);
  qkt(pA0, pA1, K_lds, qr, negm, r32, hi); partialSM<true>(pA0, pA1, mhat, negm, alA);
  SWAIT(); __syncthreads();
  int sm = 2, s0 = 0, s1 = 1;
  for (int j = 1; j + 1 < NT; j += 2) {
    SBAR(); qkt(pB0, pB1, K_lds + s1 * (int)SHM_K, qr, negm, r32, hi);
    finishSM(pA0, pA1, alA, l_reg, pa0, pa1, pa2, pa3); SBAR();
    SLOAD(sm, (j + 1) * KVBLK); SBAR();
    pvT(o, vb0 + s0 * (int)SHM_V, pa0, pa1, pa2, pa3); partialSM<false>(pB0, pB1, mhat, negm, alB);
    RESC(alB); SWAIT(); __syncthreads(); ROT();
    SBAR(); qkt(pA0, pA1, K_lds + s1 * (int)SHM_K, qr, negm, r32, hi);
    finishSM(pB0, pB1, alB, l_reg, pa0, pa1, pa2, pa3); SBAR();
    SLOAD(sm, (j + 2) * KVBLK); SBAR();
    pvT(o, vb0 + s0 * (int)SHM_V, pa0, pa1, pa2, pa3); partialSM<false>(pA0, pA1, mhat, negm, alA);
    RESC(alA); SWAIT(); __syncthreads(); ROT();
  }
  SBAR(); qkt(pB0, pB1, K_lds + s1 * (int)SHM_K, qr, negm, r32, hi);
  finishSM(pA0, pA1, alA, l_reg, pa0, pa1, pa2, pa3); SBAR();
  pvT(o, vb0 + s0 * (int)SHM_V, pa0, pa1, pa2, pa3); partialSM<false>(pB0, pB1, mhat, negm, alB);
  RESC(alB);
  finishSM(pB0, pB1, alB, l_reg, pa0, pa1, pa2, pa3); SBAR();
  pvT(o, vb0 + s1 * (int)SHM_V, pa0, pa1, pa2, pa3);
#undef ROT
  { const float rl = __builtin_amdgcn_rcpf(l_reg);
#pragma unroll
    for (int d0 = 0; d0 < 4; ++d0)
#pragma unroll
      for (int r = 0; r < 16; ++r) o[d0][r] *= rl; }
  __syncthreads();
#undef SLOAD
#undef DMA16
#undef SWAIT
#undef RESC
}

constexpr size_t SHM_STASH = SHM_ATTN;
__device__ __forceinline__ void attn_pair_unit(const bf16_t* Qb, const bf16_t* Kh, const bf16_t* Vh, bf16_t* Ob, int seq, char* lds, float lam, const float* subg) {
  {
    f32x16 o[4];
    attn_core(Qb, Kh, Vh, seq, lds, o);
    const int tid = opq((int)threadIdx.x); unsigned* stash = (unsigned*)(lds + SHM_STASH) + (tid >> 6) * 2048 + (tid & 63);
#pragma unroll
    for (int r = 0; r < 16; ++r) { stash[(2 * r) * 64] = cvtpk(o[0][r], o[1][r]); stash[(2 * r + 1) * 64] = cvtpk(o[2][r], o[3][r]); }
  }
  {
    f32x16 o[4];
    attn_core(Qb + 64, Kh + 64, Vh, seq, lds, o);
    const int tid = opq((int)threadIdx.x), wid = tid >> 6, lane = tid & 63, r32 = lane & 31, hi = lane >> 5;
    const unsigned* stash = (const unsigned*)(lds + SHM_STASH) + wid * 2048 + lane;
    float ss = 0.f;
#pragma unroll
    for (int r = 0; r < 16; ++r) { const unsigned w0 = stash[(2 * r) * 64], w1 = stash[(2 * r + 1) * 64];
      o[0][r] = __uint_as_float(w0 << 16) - lam * o[0][r]; o[1][r] = __uint_as_float(w0 & 0xffff0000u) - lam * o[1][r];
      o[2][r] = __uint_as_float(w1 << 16) - lam * o[2][r]; o[3][r] = __uint_as_float(w1 & 0xffff0000u) - lam * o[3][r];
      ss += (o[0][r] * o[0][r] + o[1][r] * o[1][r]) + (o[2][r] * o[2][r] + o[3][r] * o[3][r]); }
    { auto rr = __builtin_amdgcn_permlane32_swap(__float_as_uint(ss), __float_as_uint(ss), false, false);
      ss = __uint_as_float(rr[0]) + __uint_as_float(rr[1]); }
    const float rs = 0.8f / sqrtf(ss * (1.0f / 128.0f) + 1e-6f);
    bf16_t* Ow = Ob + (long)(wid * QBLK + r32) * 1024 + 4 * hi;
    typedef unsigned u32x2 __attribute__((ext_vector_type(2))); typedef float f32x4_t __attribute__((ext_vector_type(4)));
#pragma unroll
    for (int d0 = 0; d0 < 4; ++d0)
#pragma unroll
      for (int rq = 0; rq < 4; ++rq) { const int dv = 32 * d0 + 8 * rq;
        const f32x4_t g = *(const f32x4_t*)(subg + dv + 4 * hi);
        u32x2 w; w.x = cvtpk(o[d0][4 * rq] * rs * g[0], o[d0][4 * rq + 1] * rs * g[1]); w.y = cvtpk(o[d0][4 * rq + 2] * rs * g[2], o[d0][4 * rq + 3] * rs * g[3]);
        *(u32x2*)(Ow + dv) = w; }
  }
}
}

constexpr size_t MiB = 1u << 20;
constexpr size_t WS_CTL = 0, CTL_ZERO_BYTES = 65536;
constexpr size_t WS_MOD = 1 * MiB;
constexpr size_t WS_COS = 2 * MiB, WS_SIN = 10 * MiB;
constexpr size_t WS_AE = 18 * MiB, WS_APOS = 20 * MiB, WS_AW = 22 * MiB;
constexpr size_t WS_TOK = 24 * MiB, WS_WSLOT = 26 * MiB, WS_SLOTOF = 28 * MiB, WS_TILEE = 30 * MiB;
constexpr size_t WS_WSB = 31 * MiB;
constexpr size_t WS_WRT = 31 * MiB + 512 * 1024;
constexpr size_t WS_WQKV = 32 * MiB, WS_WO = 38 * MiB, WS_WSGIN = 40 * MiB, WS_WSGOUT = 48 * MiB;
constexpr size_t WS_WGU = 56 * MiB;
constexpr size_t WS_WD = 121 * MiB;
constexpr size_t WS_WSD = 153 * MiB;
constexpr size_t WS_ACT = 156 * MiB;
constexpr size_t WS_A0 = WS_ACT;
constexpr size_t WS_Q = WS_ACT + 128 * MiB, WS_K = WS_ACT + 256 * MiB, WS_V = WS_ACT + 384 * MiB, WS_OS = WS_ACT + 512 * MiB;
constexpr size_t WS_HMOE = WS_ACT + 128 * MiB;
constexpr size_t WS_Y = WS_ACT + 368 * MiB;
constexpr size_t WS_Z = WS_ACT + 256 * MiB;
constexpr size_t WS_WRP = WS_ACT + 832 * MiB;
constexpr size_t WS_RC = WS_WRP + 4 * MiB;
constexpr size_t WS_END = WS_RC + 1 * MiB;
static_assert(WS_WGU + (size_t)65 * 512 * 1024 * 2 <= WS_WD && WS_WD + (size_t)64 * 1024 * 256 * 2 <= WS_WSD && WS_WSD + 1024 * 256 * 2 <= WS_ACT, "weights map");
static_assert(WS_K - WS_Q == WS_V - WS_K, "Q/K/V equally spaced");
static_assert(WS_HMOE + (size_t)(T + MAXRT * 256) * 256 * 2 <= WS_Y && WS_Y + (size_t)(T + MAXRT * 256) * 1024 <= WS_WRP && WS_Z + (size_t)T * 4096 * 2 <= WS_WRP && WS_WD + (size_t)64 * 1024 * 256 * 2 == WS_WSD, "moe map");
static_assert(WS_TOK + (size_t)(T + MAXRT * 256) * 4 <= WS_WSLOT && WS_WSLOT + (size_t)(T + MAXRT * 256) * 4 <= WS_SLOTOF && WS_SLOTOF + (size_t)TK * 4 <= WS_TILEE, "dispatch map");
constexpr int CW_BAR = 4096, CW_CNT = 8192;

constexpr size_t CV_OUT_OFF = (size_t)128 * MiB;
#ifndef CV_SPLIT
#define CV_SPLIT (65 * 384 * 35 / 100)
#endif
constexpr int RING_BYTES = 131072, LDSCTL_OFF = 143360, MISC_OFF = LDSCTL_OFF + 320, LDS_BYTES = 147456;

#define GAS __attribute__((address_space(1)))
#define LAS __attribute__((address_space(3)))
typedef unsigned short bf16;
typedef unsigned v4u __attribute__((ext_vector_type(4)));
typedef unsigned v2u __attribute__((ext_vector_type(2)));
typedef float f32x4 __attribute__((ext_vector_type(4)));
typedef float f32x16 __attribute__((ext_vector_type(16)));
typedef short bf16x8 __attribute__((ext_vector_type(8)));
typedef GAS unsigned gu32;
#define RLX_AGENT __ATOMIC_RELAXED, __HIP_MEMORY_SCOPE_AGENT
#define LDS_WAIT() asm volatile("s_waitcnt lgkmcnt(0)" ::: "memory")
#define VM_WAIT() asm volatile("s_waitcnt vmcnt(0)" ::: "memory")
__device__ __forceinline__ unsigned f2bf(float f) { unsigned u = __builtin_bit_cast(unsigned, f); return (u + 0x7fffu + ((u >> 16) & 1u)) >> 16; }
__device__ __forceinline__ unsigned pk2(float lo, float hi) { return f2bf(lo) | (f2bf(hi) << 16); }
__device__ __forceinline__ float bflo(unsigned w) { return __uint_as_float(w << 16); }
__device__ __forceinline__ float bfhi(unsigned w) { return __uint_as_float(w & 0xffff0000u); }
__device__ __forceinline__ int ld_agent(const int* p) { return (int)__hip_atomic_load((const unsigned*)p, RLX_AGENT); }

#define XB_TMO      128
#define XB_XCNT(j)  (256  + 64 * (j))
#define XB_XSUB(j)  (1280 + 64 * (j))
#define XB_XGEN(j)  (2304 + 64 * (j))
#define XB_TOP      3328
#define XB_TOPGEN   3392
#define XCD_BAR_WORDS 3456
#define XB_SPIN_CAP (1u << 22)

__device__ __forceinline__ unsigned xb_ld(unsigned* p)              { return __hip_atomic_load(p, __ATOMIC_RELAXED, __HIP_MEMORY_SCOPE_AGENT); }
__device__ __forceinline__ unsigned xb_add(unsigned* p, unsigned v) { return __hip_atomic_fetch_add(p, v, __ATOMIC_RELAXED, __HIP_MEMORY_SCOPE_AGENT); }
__device__ __forceinline__ unsigned xb_xcc_id() { return (unsigned)__builtin_amdgcn_s_getreg((3 << 11) | 20) & 0xFu; }
#define XB_SPIN(cond, bar) do { unsigned _sp = 0; while (cond) { __builtin_amdgcn_s_sleep(1); \
    if ((++_sp & 255u) == 0u) { if (xb_ld(&(bar)[XB_TMO])) break; if (_sp > XB_SPIN_CAP) { atomicAdd(&(bar)[XB_TMO], 1u); break; } } } } while (0)

struct XcdBarrier { unsigned* bar; unsigned x; volatile LAS unsigned* st; };

__device__ __forceinline__ XcdBarrier xcd_barrier_post(unsigned* bar, volatile LAS unsigned* st) {
    XcdBarrier b; b.bar = bar; b.x = xb_xcc_id(); b.st = st;
    if (threadIdx.x == 0) (void)xb_add(&bar[XB_XCNT(b.x)], 1u);
    return b;
}
__device__ __forceinline__ void xcd_barrier_complete(unsigned* bar, unsigned x, unsigned& nloc, unsigned& nx) {
    const unsigned G = gridDim.x * gridDim.y * gridDim.z;
    unsigned sum, cnt, mine, sp = 0u;
    for (;;) {
        sum = 0u; cnt = 0u; mine = 0u;
#pragma unroll
        for (unsigned j = 0; j < 16; ++j) { const unsigned c = xb_ld(&bar[XB_XCNT(j)]); sum += c; cnt += (c > 0u) ? 1u : 0u; mine = (j == x) ? c : mine; }
        if (sum == G) break;
        __builtin_amdgcn_s_sleep(1);
        if ((++sp & 255u) == 0u) { if (xb_ld(&bar[XB_TMO])) break; if (sp > XB_SPIN_CAP) { atomicAdd(&bar[XB_TMO], 1u); break; } }
    }
    nloc = mine > 0u ? mine : 1u; nx = cnt > 0u ? cnt : 1u;
}
__device__ __forceinline__ void xcd_barrier(const XcdBarrier& b) {
    asm volatile("s_waitcnt vmcnt(0)" ::: "memory");
    __syncthreads();
    if (threadIdx.x == 0) {
        unsigned* bar = b.bar;
        __builtin_amdgcn_s_waitcnt(0);
        unsigned nloc = b.st[0], nx = b.st[1];
        if (nloc == 0u) { xcd_barrier_complete(bar, b.x, nloc, nx); b.st[0] = nloc; b.st[1] = nx; }
        const unsigned old = xb_add(&bar[XB_XSUB(b.x)], 1u);
        const unsigned gen = old / nloc;
        if (old + 1u == (gen + 1u) * nloc) {
            __builtin_amdgcn_fence(__ATOMIC_RELEASE, "agent");
            asm volatile("s_waitcnt vmcnt(0)" ::: "memory");
            const unsigned og = xb_add(&bar[XB_TOP], 1u);
            const unsigned tg = og / nx;
            if (og + 1u == (tg + 1u) * nx) xb_add(&bar[XB_TOPGEN], 1u);
            else XB_SPIN(xb_ld(&bar[XB_TOPGEN]) == tg, bar);
            __builtin_amdgcn_fence(__ATOMIC_ACQUIRE, "agent");
            xb_add(&bar[XB_XGEN(b.x)], 1u);
            asm volatile("s_waitcnt vmcnt(0)" ::: "memory");
        } else {
            XB_SPIN(xb_ld(&bar[XB_XGEN(b.x)]) == gen, bar);
            __builtin_amdgcn_fence(__ATOMIC_ACQUIRE, "agent");
            asm volatile("s_waitcnt vmcnt(0)" ::: "memory");
        }
    }
    __syncthreads();
}

struct Frame { LAS unsigned char* lds; int wave, vcu, G; };
struct Args { const float* in[29]; float* out; unsigned char* ws; };
typedef __attribute__((address_space(4))) const unsigned char* kargp_t;
__device__ __forceinline__ kargp_t kargs() { kargp_t p = (kargp_t)__builtin_amdgcn_kernarg_segment_ptr(); asm volatile("" : "+s"(p)); return p; }
__device__ __forceinline__ const float* kin(int i) { return *(const float* const __attribute__((address_space(4)))*)(kargs() + 8 * i); }
__device__ __forceinline__ float* kout() { return *(float* const __attribute__((address_space(4)))*)(kargs() + 8 * 29); }
__device__ __forceinline__ unsigned char* kws() { return *(unsigned char* const __attribute__((address_space(4)))*)(kargs() + 8 * 30); }

__device__ __forceinline__ float wave_sum(float v) {
#define WS_STEP(M) v += __uint_as_float((unsigned)__builtin_amdgcn_ds_swizzle((int)__float_as_uint(v), ((M) << 10) | 0x1F))
    WS_STEP(1); WS_STEP(2); WS_STEP(4); WS_STEP(8); WS_STEP(16);
#undef WS_STEP
    { auto rr = __builtin_amdgcn_permlane32_swap(__float_as_uint(v), __float_as_uint(v), false, false); v = __uint_as_float(rr[0]) + __uint_as_float(rr[1]); }
    return v;
}

template <class ColF> __device__ __forceinline__ void transpose_item(const float* W, int ldw, int k0, ColF colf, bf16* WT, int Kd, int drow0, LAS float* scr, int lane) {
    const int j = lane & 31; const int sc = colf(j);
    float tv[32];
#pragma unroll
    for (int i = 0; i < 32; ++i) tv[i] = W[(size_t)(k0 + 2 * i + (lane >> 5)) * ldw + sc];
#pragma unroll
    for (int i = 0; i < 32; ++i) scr[(2 * i + (lane >> 5)) * 33 + j] = tv[i];
    LDS_WAIT(); asm volatile("" ::: "memory");
    const int c = lane & 7;
#pragma unroll
    for (int jj = 0; jj < 4; ++jj) { const int n = (lane >> 3) + 8 * jj; const LAS float* s = scr + (8 * c) * 33 + n;
        v4u o; o.x = pk2(s[0 * 33], s[1 * 33]); o.y = pk2(s[2 * 33], s[3 * 33]); o.z = pk2(s[4 * 33], s[5 * 33]); o.w = pk2(s[6 * 33], s[7 * 33]);
        *(GAS v4u*)(WT + (size_t)(drow0 + n) * Kd + k0 + 8 * c) = o; }
    LDS_WAIT(); asm volatile("" ::: "memory");
}
struct ColId { int c0; __device__ __forceinline__ int operator()(int j) const { return c0 + j; } };
struct ColQK { int n0; __device__ __forceinline__ int operator()(int j) const { const int n = n0 + j; if (n >= 2048) return n; const int hb = n >> 6, p = n & 63, g = p >> 3, i = p & 7;
    return 64 * hb + (i < 4 ? 4 * g + i : 32 + 4 * g + (i - 4)); } };

struct CvI { const float* W; int ldw, k0, c0; bf16* WT; int Kd, drow0; };
__device__ __forceinline__ CvI cv_item(int it, int l, bf16* base) {
    constexpr int PER_E = 256 + 128; CvI I;
    const int e = it / PER_E; int r = it % PER_E;
    if (r < 256) { const int kb = r >> 4, nb = r & 15; const int pn = nb >> 3, rr = (nb & 7) * 32; const bool up = rr >= 128;
        I.W = e < 64 ? (up ? kin(23) : kin(22)) + ((size_t)l * 64 + e) * 1024 * 256 : (up ? kin(26) : kin(25)) + (size_t)l * 1024 * 256;
        I.ldw = 256; I.k0 = kb * 64; I.c0 = 128 * pn + (up ? rr - 128 : rr); I.WT = base; I.Kd = 1024; I.drow0 = e * 512 + nb * 32;
    } else { r -= 256; const int kb = r >> 5, nb = r & 31;
        I.W = e < 64 ? kin(24) + ((size_t)l * 64 + e) * 256 * 1024 : kin(27) + (size_t)l * 256 * 1024;
        I.ldw = 1024; I.k0 = kb * 64; I.c0 = nb * 32; I.WT = base + (size_t)65 * 512 * 1024; I.Kd = 256; I.drow0 = e * 1024 + nb * 32; }
    return I;
}
__device__ __forceinline__ void cv_load(const CvI& I, float (&tv)[32], int lane) {
    const int sc = I.c0 + (lane & 31);
#pragma unroll
    for (int i = 0; i < 32; ++i) tv[i] = I.W[(size_t)(I.k0 + 2 * i + (lane >> 5)) * I.ldw + sc];
}
__device__ __forceinline__ void cv_store(const CvI& I, const float (&tv)[32], LAS float* scr, int lane) {
    const int j = lane & 31;
#pragma unroll
    for (int i = 0; i < 32; ++i) scr[(2 * i + (lane >> 5)) * 33 + j] = tv[i];
    LDS_WAIT(); asm volatile("" ::: "memory");
    const int c = lane & 7;
#pragma unroll
    for (int jj = 0; jj < 4; ++jj) { const int n = (lane >> 3) + 8 * jj; const LAS float* sp = scr + (8 * c) * 33 + n;
        v4u o; o.x = pk2(sp[0 * 33], sp[1 * 33]); o.y = pk2(sp[2 * 33], sp[3 * 33]); o.z = pk2(sp[4 * 33], sp[5 * 33]); o.w = pk2(sp[6 * 33], sp[7 * 33]);
        *(GAS v4u*)(I.WT + (size_t)(I.drow0 + n) * I.Kd + I.k0 + 8 * c) = o; }
    LDS_WAIT(); asm volatile("" ::: "memory");
}
constexpr int CV_NITEMS = 65 * 384;
__device__ __forceinline__ void convert_moe_weights(const Frame& F, int l, bf16* base, int it0, int it1, int gw, int NGW) {
    LAS float* scr = (LAS float*)(F.lds + F.wave * 17408);
    const int lane = (opq((int)threadIdx.x) & 63);
#pragma unroll 1
    for (int it = it0 + gw; it < it1; it += NGW) {
        const CvI A = cv_item(it, l, base);
        float ta[32];
        cv_load(A, ta, lane);
        cv_store(A, ta, scr, lane);
    }
}

__constant__ float c_inv_freq[32] = {
    1.000000000e+00f, 7.498942614e-01f, 5.623413324e-01f, 4.216965139e-01f, 3.162277639e-01f, 2.371373773e-01f, 1.778279394e-01f, 1.333521307e-01f,
    1.000000015e-01f, 7.498941571e-02f, 5.623413250e-02f, 4.216965288e-02f, 3.162277490e-02f, 2.371373773e-02f, 1.778279431e-02f, 1.333521493e-02f,
    9.999999776e-03f, 7.498941850e-03f, 5.623413250e-03f, 4.216964822e-03f, 3.162277630e-03f, 2.371373586e-03f, 1.778279431e-03f, 1.333521446e-03f,
    1.000000047e-03f, 7.498942432e-04f, 5.623413017e-04f, 4.216965172e-04f, 3.162277571e-04f, 2.371373703e-04f, 1.778279402e-04f, 1.333521504e-04f };

__device__ __forceinline__ void phase_prologue(const Frame& F, const Args& a) {
    const int tid = opq((int)threadIdx.x), lane = tid & 63, wave = F.wave;
    if (blockIdx.x < 192) {
        LAS float* cond = (LAS float*)F.lds; LAS float* red = (LAS float*)(F.lds + 32768);
        for (int i = tid; i < 8 * 1024; i += 512) { const float c = kin(1)[i]; cond[i] = c / (1.0f + __expf(-c)); }
        __syncthreads();
        const int l = blockIdx.x / 96, jb = blockIdx.x % 96, j = jb * 64 + lane;
        const float* W = kin(5) + (size_t)l * 1024 * 6144;
        float acc[8];
#pragma unroll
        for (int b = 0; b < 8; ++b) acc[b] = 0.f;
#pragma unroll 4
        for (int kk = 0; kk < 128; ++kk) { const int k = wave * 128 + kk; const float wv = W[(size_t)k * 6144 + j];
#pragma unroll
            for (int b = 0; b < 8; ++b) acc[b] += cond[b * 1024 + k] * wv; }
#pragma unroll
        for (int b = 0; b < 8; ++b) red[(wave * 8 + b) * 64 + lane] = acc[b];
        __syncthreads();
        { const int b = tid >> 6; float s = 0.f;
#pragma unroll
          for (int w = 0; w < 8; ++w) s += red[(w * 8 + b) * 64 + lane];
          ((float*)(kws() + WS_MOD))[(size_t)(l * 8 + b) * 6144 + j] = s + kin(6)[l * 6144 + j]; }
        __syncthreads();
    }
    { float* cosT = (float*)(kws() + WS_COS); float* sinT = (float*)(kws() + WS_SIN); const int* pos = (const int*)kin(2);
      for (int i = blockIdx.x * 512 + tid; i < T * 32; i += F.G * 512) { const int t = i >> 5, j = i & 31;
          const float ang = (float)pos[t] * c_inv_freq[j];
          const double rev = (double)ang * 0.15915494309189535; const float fr = (float)(rev - __builtin_rint(rev));
          cosT[i] = __builtin_amdgcn_cosf(fr); sinT[i] = __builtin_amdgcn_sinf(fr); } }
    { bf16* wsb = (bf16*)(kws() + WS_WSB); for (int i = blockIdx.x * 512 + tid; i < 8 * 128 * 128; i += F.G * 512) wsb[i] = (bf16)f2bf(kin(17)[i]); }
    { bf16* wrt = (bf16*)(kws() + WS_WRT); for (int i = blockIdx.x * 512 + tid; i < 2 * 1024 * 64; i += F.G * 512) { const int l = i >> 16, k = (i >> 6) & 1023, e = i & 63;
        const float w = kin(20)[i]; const unsigned hi = f2bf(w); const unsigned lo = f2bf(w - __uint_as_float(hi << 16));
        wrt[((size_t)(l * 2 + 0) * 64 + e) * 1024 + k] = (bf16)hi; wrt[((size_t)(l * 2 + 1) * 64 + e) * 1024 + k] = (bf16)lo; } }
    LAS float* scr = (LAS float*)(F.lds + wave * 17408);
    const int gw = F.vcu * NWAVES + wave, NGW = F.G * NWAVES;
    constexpr int I_QKV = 16 * 96, I_WO = 16 * 32, I_SGIN = 16 * 128, I_SGOUT = 32 * 32;
    for (int it = gw; it < I_QKV + I_WO + I_SGIN + I_SGOUT; it += NGW) {
        int r = it;
        if (r < I_QKV) { const int kb = r / 96, nb = r % 96; transpose_item(kin(7), 3072, kb * 64, ColQK{nb * 32}, (bf16*)(kws() + WS_WQKV), 1024, nb * 32, scr, lane); continue; } r -= I_QKV;
        if (r < I_WO) { const int kb = r / 32, nb = r % 32; transpose_item(kin(13), 1024, kb * 64, ColId{nb * 32}, (bf16*)(kws() + WS_WO), 1024, nb * 32, scr, lane); continue; } r -= I_WO;
        if (r < I_SGIN) { const int kb = r / 128, nb = r % 128; transpose_item(kin(14), 4096, kb * 64, ColId{nb * 32}, (bf16*)(kws() + WS_WSGIN), 1024, nb * 32, scr, lane); continue; } r -= I_SGIN;
        { const int kb = r / 32, nb = r % 32; transpose_item(kin(19), 1024, kb * 64, ColId{nb * 32}, (bf16*)(kws() + WS_WSGOUT), 2048, nb * 32, scr, lane); }
    }
    convert_moe_weights(F, 0, (bf16*)((unsigned char*)kout() + CV_OUT_OFF), 0, CV_NITEMS, F.vcu * NWAVES + wave, F.G * NWAVES);
    __syncthreads();
}

__device__ __forceinline__ void phase_norm(const Frame& F, const float* x, const float* ng, const float* shift, const float* scale, bf16* H) {
    const int gw = F.vcu * NWAVES + F.wave, NGW = F.G * NWAVES, lane = (opq((int)threadIdx.x) & 63);
    f32x4 g4[4];
#pragma unroll
    for (int j = 0; j < 4; ++j) g4[j] = *(const f32x4*)(ng + 4 * lane + 256 * j);
    for (int row = 2 * gw; row < T; row += 2 * NGW) { const int b = row / SEQ;
        f32x4 v[2][4], sc4[4], sh4[4];
#pragma unroll
        for (int r2 = 0; r2 < 2; ++r2) { const GAS f32x4* xr = (const GAS f32x4*)(x + (size_t)(row + r2) * 1024) + lane;
#pragma unroll
            for (int j = 0; j < 4; ++j) v[r2][j] = xr[64 * j]; }
#pragma unroll
        for (int j = 0; j < 4; ++j) { const int col = 4 * lane + 256 * j; sc4[j] = *(const f32x4*)(scale + (size_t)b * 6144 + col); sh4[j] = *(const f32x4*)(shift + (size_t)b * 6144 + col); }
        float ss0 = 0.f, ss1 = 0.f;
#pragma unroll
        for (int j = 0; j < 4; ++j) { ss0 += (v[0][j].x * v[0][j].x + v[0][j].y * v[0][j].y) + (v[0][j].z * v[0][j].z + v[0][j].w * v[0][j].w);
                                      ss1 += (v[1][j].x * v[1][j].x + v[1][j].y * v[1][j].y) + (v[1][j].z * v[1][j].z + v[1][j].w * v[1][j].w); }
        const float rstd0 = 1.0f / sqrtf(wave_sum(ss0) * (1.0f / 1024.0f) + EPS), rstd1 = 1.0f / sqrtf(wave_sum(ss1) * (1.0f / 1024.0f) + EPS);
#pragma unroll
        for (int r2 = 0; r2 < 2; ++r2) { const float rstd = r2 == 0 ? rstd0 : rstd1; GAS v2u* o8 = (GAS v2u*)(H + (size_t)(row + r2) * 1024) + lane;
#pragma unroll
            for (int j = 0; j < 4; ++j) { const f32x4 h = v[r2][j] * rstd * g4[j] * (sc4[j] + 1.0f) + sh4[j];
                v2u w; w.x = pk2(h.x, h.y); w.y = pk2(h.z, h.w); o8[64 * j] = w; } }
    }
}

__device__ __forceinline__ void phase_attn(const Frame& F, const bf16* Q, const bf16* K, const bf16* V, bf16* Ob, char* lds) {
    const int lane = (opq((int)threadIdx.x) & 63);
    const float s1 = wave_sum(kin(8)[lane] * kin(9)[lane]), s2 = wave_sum(kin(10)[lane] * kin(11)[lane]);
    const float lam = __uint_as_float(__builtin_amdgcn_readfirstlane(__float_as_uint(__expf(s1) - __expf(s2) + 0.2f)));
    for (int U = F.vcu; U < BATCH * 8 * 32; U += F.G) { const int bh = U >> 5, qb = U & 31, b = bh >> 3, h = bh & 7;
        const size_t row0 = (size_t)b * SEQ + (size_t)qb * 256;
        att::attn_pair_unit(Q + row0 * 1024 + h * 128, K + (size_t)b * SEQ * 1024 + h * 128, V + (size_t)b * SEQ * 1024 + h * 128, Ob + row0 * 1024 + h * 128, SEQ, lds, lam, kin(12));
    }
}

__device__ __forceinline__ void phase_diff(const Frame& F, const Args& a, const bf16* OS, bf16* Ob) {
    const int gw = F.vcu * NWAVES + F.wave, NGW = F.G * NWAVES, lane = (opq((int)threadIdx.x) & 63);
    const float s1 = wave_sum(kin(8)[lane] * kin(9)[lane]), s2 = wave_sum(kin(10)[lane] * kin(11)[lane]);
    const float lam = __expf(s1) - __expf(s2) + 0.2f;
    const float g0 = kin(12)[2 * lane] * 0.8f, g1 = kin(12)[2 * lane + 1] * 0.8f;
    for (int row = 2 * gw; row < T; row += 2 * NGW) {
        unsigned wa[2][8], wb[2][8];
#pragma unroll
        for (int r2 = 0; r2 < 2; ++r2) { const GAS unsigned* src = (const GAS unsigned*)(OS + (size_t)(row + r2) * 2048) + lane;
#pragma unroll
            for (int h = 0; h < 8; ++h) { wa[r2][h] = src[(2 * h) * 64]; wb[r2][h] = src[(2 * h + 1) * 64]; } }
#pragma unroll
        for (int r2 = 0; r2 < 2; ++r2) { GAS unsigned* dst = (GAS unsigned*)(Ob + (size_t)(row + r2) * 1024) + lane;
#pragma unroll
            for (int h = 0; h < 8; ++h) { const float d0 = bflo(wa[r2][h]) - lam * bflo(wb[r2][h]), d1 = bfhi(wa[r2][h]) - lam * bfhi(wb[r2][h]);
                const float r = 1.0f / sqrtf(wave_sum(d0 * d0 + d1 * d1) * (1.0f / 128.0f) + EPS);
                dst[h * 64] = pk2(d0 * r * g0, d1 * r * g1); } }
    }
}

__device__ __forceinline__ int rt_expert(int i) { return 32 * (i >> 5) + 16 * ((i >> 2) & 1) + (i & 3) + 4 * ((i & 31) >> 3); }
__device__ __forceinline__ void router_precompute(const Frame& F) {
    const int tid = opq((int)threadIdx.x), lane = tid & 63;
    const float* modp = (const float*)(kws() + WS_MOD);
    bf16* WrP = (bf16*)(kws() + WS_WRP); float* rc = (float*)(kws() + WS_RC);
    for (int it = F.vcu * 512 + tid; it < 2 * 8 * 64 * 128; it += F.G * 512) {
        const int kc = it & 127, i = (it >> 7) & 63, b = (it >> 13) & 7, l = it >> 16, e = rt_expert(i);
        const float* wr = kin(20) + (size_t)l * 1024 * 64 + e; const float* g = kin(4) + l * 1024; const float* sc = modp + ((size_t)l * 8 + b) * 6144 + 4 * 1024;
        unsigned hi[4], lo[4];
#pragma unroll
        for (int j = 0; j < 4; ++j) { const int k = 8 * kc + 2 * j;
            const float v0 = g[k] * (sc[k] + 1.0f) * wr[(size_t)k * 64], v1 = g[k + 1] * (sc[k + 1] + 1.0f) * wr[(size_t)(k + 1) * 64];
            hi[j] = pk2(v0, v1); lo[j] = pk2(v0 - bflo(hi[j]), v1 - bfhi(hi[j])); }
        bf16* dst = WrP + ((((size_t)l * 8 + b) * 2) * 64 + i) * 1024 + 8 * kc;
        *(GAS v4u*)dst = (v4u){hi[0], hi[1], hi[2], hi[3]}; *(GAS v4u*)(dst + 64 * 1024) = (v4u){lo[0], lo[1], lo[2], lo[3]};
    }
    for (int o = F.vcu * NWAVES + F.wave; o < 2 * 8 * 64; o += F.G * NWAVES) { const int e = o & 63, b = (o >> 6) & 7, l = o >> 9;
        const float* wr = kin(20) + (size_t)l * 1024 * 64 + e; const float* sh = modp + ((size_t)l * 8 + b) * 6144 + 3 * 1024;
        float s = 0.f;
#pragma unroll
        for (int j = 0; j < 16; ++j) { const int k = lane + 64 * j; s += sh[k] * wr[(size_t)k * 64]; }
        s = wave_sum(s); if (lane == 0) rc[o] = s; }
}

__device__ __forceinline__ void phase_norm_router(const Frame& F, const bf16* x, const float* ng, const float* modl, const bf16* WrP, const float* rc, const float* rbias,
                                                  bf16* H2, int* a_e, int* a_pos, float* a_w, gu32* gcount) {
    const int tid = opq((int)threadIdx.x), lane = tid & 63, wave = F.wave, mi = lane & 31, kh = lane >> 5;
    LAS float* rstd_s = (LAS float*)F.lds;
    LAS int* hist = (LAS int*)(F.lds + 1024);
    LAS int* base = hist + 64;
    LAS float* cb = (LAS float*)(base + 64);
    LAS float* rb = cb + 64;
    LAS int* se = (LAS int*)(F.lds + 4096);
    LAS float* ssc = (LAS float*)(se + 1536);
    LAS int* slp = (LAS int*)(ssc + 1536);
    for (int blk = F.vcu; blk < T / 256; blk += F.G) { const int row0 = blk * 256, b = row0 / SEQ, r0 = row0 + wave * 32;
        if (tid < 64) { hist[tid] = 0; cb[tid] = rc[b * 64 + tid]; rb[tid] = rbias[tid]; }
        __syncthreads();
        {
            f32x4 A4[2][2], S4[2][2];
#pragma unroll
            for (int j = 0; j < 2; ++j)
#pragma unroll
                for (int q = 0; q < 2; ++q) { const int col = 8 * lane + 512 * j + 4 * q;
                    A4[j][q] = *(const f32x4*)(ng + col) * (*(const f32x4*)(modl + (size_t)b * 6144 + 4 * 1024 + col) + 1.0f); S4[j][q] = *(const f32x4*)(modl + (size_t)b * 6144 + 3 * 1024 + col); }
            v4u xw[2][2];
#pragma unroll
            for (int r2 = 0; r2 < 2; ++r2)
#pragma unroll
                for (int j = 0; j < 2; ++j) xw[r2][j] = *(const GAS v4u*)(x + (size_t)(r0 + r2) * 1024 + 8 * lane + 512 * j);
#pragma unroll 1
            for (int it = 0; it < 16; ++it) {
                v4u xn[2][2]; const int rn = r0 + (it < 15 ? 2 * it + 2 : 2 * it);
#pragma unroll
                for (int r2 = 0; r2 < 2; ++r2)
#pragma unroll
                    for (int j = 0; j < 2; ++j) xn[r2][j] = *(const GAS v4u*)(x + (size_t)(rn + r2) * 1024 + 8 * lane + 512 * j);
                f32x4 v[2][2][2]; float ss[2];
#pragma unroll
                for (int r2 = 0; r2 < 2; ++r2) { float s = 0.f;
#pragma unroll
                    for (int j = 0; j < 2; ++j) { const v4u w = xw[r2][j];
                        v[r2][j][0] = (f32x4){bflo(w.x), bfhi(w.x), bflo(w.y), bfhi(w.y)}; v[r2][j][1] = (f32x4){bflo(w.z), bfhi(w.z), bflo(w.w), bfhi(w.w)};
#pragma unroll
                        for (int q = 0; q < 2; ++q) s += (v[r2][j][q].x * v[r2][j][q].x + v[r2][j][q].y * v[r2][j][q].y) + (v[r2][j][q].z * v[r2][j][q].z + v[r2][j][q].w * v[r2][j][q].w); }
                    ss[r2] = s; }
                const float rstd0 = 1.0f / sqrtf(wave_sum(ss[0]) * (1.0f / 1024.0f) + EPS), rstd1 = 1.0f / sqrtf(wave_sum(ss[1]) * (1.0f / 1024.0f) + EPS);
#pragma unroll
                for (int r2 = 0; r2 < 2; ++r2) { const int row = r0 + 2 * it + r2; const float rstd = r2 == 0 ? rstd0 : rstd1;
#pragma unroll
                    for (int j = 0; j < 2; ++j) { const int col = 8 * lane + 512 * j;
                        const f32x4 h0 = v[r2][j][0] * rstd * A4[j][0] + S4[j][0], h1 = v[r2][j][1] * rstd * A4[j][1] + S4[j][1];
                        v4u w; w.x = pk2(h0.x, h0.y); w.y = pk2(h0.z, h0.w); w.z = pk2(h1.x, h1.y); w.w = pk2(h1.z, h1.w);
                        *(GAS v4u*)(H2 + (size_t)row * 1024 + col) = w; } }
                if (lane == 0) { rstd_s[wave * 32 + 2 * it] = rstd0; rstd_s[wave * 32 + 2 * it + 1] = rstd1; }
#pragma unroll
                for (int r2 = 0; r2 < 2; ++r2)
#pragma unroll
                    for (int j = 0; j < 2; ++j) xw[r2][j] = xn[r2][j];
            }
        }
        f32x16 acc0, acc1;
        { float zf = 0.f; asm volatile("" : "+v"(zf));
#pragma unroll
          for (int r = 0; r < 16; ++r) { acc0[r] = zf; acc1[r] = zf; } }
        {
            const GAS bf16* xp = (const GAS bf16*)(x + (size_t)(r0 + mi) * 1024 + 8 * kh);
            const GAS bf16* wp = (const GAS bf16*)(WrP + ((size_t)b * 128 + mi) * 1024 + 8 * kh);
            bf16x8 xf[8], wf[8][4];
#define RT_LOAD(j, s) do { const int s_ = (s); xf[j] = *(const GAS bf16x8*)(xp + 16 * s_); wf[j][0] = *(const GAS bf16x8*)(wp + 16 * s_); wf[j][1] = *(const GAS bf16x8*)(wp + 16 * s_ + 32 * 1024); \
        wf[j][2] = *(const GAS bf16x8*)(wp + 16 * s_ + 64 * 1024); wf[j][3] = *(const GAS bf16x8*)(wp + 16 * s_ + 96 * 1024); } while (0)
#pragma unroll
            for (int j = 0; j < 8; ++j) { RT_LOAD(j, j); __builtin_amdgcn_sched_barrier(0); }
#pragma unroll 1
            for (int s = 0; s < 64; s += 8) {
#pragma unroll
                for (int j = 0; j < 8; ++j) {
                    acc0 = __builtin_amdgcn_mfma_f32_32x32x16_bf16(wf[j][0], xf[j], acc0, 0, 0, 0); acc1 = __builtin_amdgcn_mfma_f32_32x32x16_bf16(wf[j][1], xf[j], acc1, 0, 0, 0);
                    acc0 = __builtin_amdgcn_mfma_f32_32x32x16_bf16(wf[j][2], xf[j], acc0, 0, 0, 0); acc1 = __builtin_amdgcn_mfma_f32_32x32x16_bf16(wf[j][3], xf[j], acc1, 0, 0, 0);
                    const int sn = s + 8 + j < 64 ? s + 8 + j : 63;
                    RT_LOAD(j, sn); __builtin_amdgcn_sched_barrier(0);
                }
            }
#undef RT_LOAD
        }
        asm volatile("s_waitcnt lgkmcnt(0)" ::: "memory");
        const float rstd = rstd_s[wave * 32 + mi];
        float sc[32], sl[32];
#pragma unroll
        for (int q = 0; q < 4; ++q) { const f32x4 c0 = *(const LAS f32x4*)(cb + 16 * kh + 4 * q), b0 = *(const LAS f32x4*)(rb + 16 * kh + 4 * q);
            const f32x4 c1 = *(const LAS f32x4*)(cb + 32 + 16 * kh + 4 * q), b1 = *(const LAS f32x4*)(rb + 32 + 16 * kh + 4 * q);
#pragma unroll
            for (int jj = 0; jj < 4; ++jj) { const int r = 4 * q + jj;
                const float s0 = 1.0f / (1.0f + __expf(-(acc0[r] * rstd + c0[jj]))), s1 = 1.0f / (1.0f + __expf(-(acc1[r] * rstd + c1[jj])));
                sc[r] = s0; sl[r] = s0 + b0[jj]; sc[16 + r] = s1; sl[16 + r] = s1 + b1[jj]; } }
        float gl[4];
#pragma unroll
        for (int q = 0; q < 4; ++q) { float m1 = -INFINITY, m2 = -INFINITY;
#pragma unroll
            for (int j = 0; j < 8; ++j) { const float v = sl[8 * q + j]; m2 = fmaxf(m2, fminf(m1, v)); m1 = fmaxf(m1, v); }
            gl[q] = m1 + m2; }
        float G[8];
        { auto r0_ = __builtin_amdgcn_permlane32_swap(__float_as_uint(gl[0]), __float_as_uint(gl[0]), false, false); G[0] = __uint_as_float(r0_[0]); G[2] = __uint_as_float(r0_[1]);
          auto r1_ = __builtin_amdgcn_permlane32_swap(__float_as_uint(gl[1]), __float_as_uint(gl[1]), false, false); G[1] = __uint_as_float(r1_[0]); G[3] = __uint_as_float(r1_[1]);
          auto r2_ = __builtin_amdgcn_permlane32_swap(__float_as_uint(gl[2]), __float_as_uint(gl[2]), false, false); G[4] = __uint_as_float(r2_[0]); G[6] = __uint_as_float(r2_[1]);
          auto r3_ = __builtin_amdgcn_permlane32_swap(__float_as_uint(gl[3]), __float_as_uint(gl[3]), false, false); G[5] = __uint_as_float(r3_[0]); G[7] = __uint_as_float(r3_[1]); }
        bool gsel[8];
#pragma unroll
        for (int g = 0; g < 8; ++g) { int rank = 0;
#pragma unroll
            for (int j = 0; j < 8; ++j) if (j != g) rank += (G[j] > G[g] || (G[j] == G[g] && j < g)) ? 1 : 0;
            gsel[g] = rank < 4; }
        { const bool f0 = kh ? gsel[2] : gsel[0], f1 = kh ? gsel[3] : gsel[1], f2 = kh ? gsel[6] : gsel[4], f3 = kh ? gsel[7] : gsel[5];
#pragma unroll
          for (int j = 0; j < 8; ++j) { sl[j] = f0 ? sl[j] : -INFINITY; sl[8 + j] = f1 ? sl[8 + j] : -INFINITY; sl[16 + j] = f2 ? sl[16 + j] : -INFINITY; sl[24 + j] = f3 ? sl[24 + j] : -INFINITY; } }
        int we[6]; float wsc[6]; float wsum = 0.f;
#pragma unroll
        for (int k = 0; k < 6; ++k) {
            float bv = -INFINITY, bs = 0.f; int bi = 0;
#pragma unroll
            for (int r = 0; r < 32; ++r) { const bool t = sl[r] > bv; bv = t ? sl[r] : bv; bi = t ? r : bi; bs = t ? sc[r] : bs; }
            const int be = 16 * kh + bi + (bi & 16);
            const auto rv = __builtin_amdgcn_permlane32_swap(__float_as_uint(bv), __float_as_uint(bv), false, false);
            const auto re = __builtin_amdgcn_permlane32_swap((unsigned)be, (unsigned)be, false, false);
            const auto rs = __builtin_amdgcn_permlane32_swap(__float_as_uint(bs), __float_as_uint(bs), false, false);
            const float lv = __uint_as_float(rv[0]), uv = __uint_as_float(rv[1]); const int le = (int)re[0], ue = (int)re[1];
            const bool lw = lv > uv || (lv == uv && le < ue);
            const int e = lw ? le : ue; we[k] = e; wsc[k] = lw ? __uint_as_float(rs[0]) : __uint_as_float(rs[1]); wsum += wsc[k];
            const int wr_ = (((e >> 4) & 1) == kh) ? ((e & 15) | ((e & 32) >> 1)) : -1;
#pragma unroll
            for (int r = 0; r < 32; ++r) sl[r] = (r == wr_) ? -INFINITY : sl[r];
        }
#pragma unroll
        for (int j = 0; j < 3; ++j) { const int e = (kh ? we[3 + j] : we[j]) & 63; const float w = (kh ? wsc[3 + j] : wsc[j]) / wsum * 2.5f;
            const int p = atomicAdd((int*)&hist[e], 1);
            const int o = (wave * 32 + mi) * 6 + 3 * kh + j; se[o] = e; ssc[o] = w; slp[o] = p; }
        __syncthreads();
        if (tid < 64) { const int c = hist[tid]; base[tid] = c ? (int)__hip_atomic_fetch_add(gcount + tid, (unsigned)c, RLX_AGENT) : 0; }
        __syncthreads();
        for (int i = tid; i < 1536; i += 512) { const int e = se[i]; a_e[row0 * 6 + i] = e; a_pos[row0 * 6 + i] = base[e] + slp[i]; a_w[row0 * 6 + i] = ssc[i]; }
        __syncthreads();
    }
}

__device__ __forceinline__ void phase_dispatch(const Frame& F, gu32* gcount, const int* a_e, const int* a_pos, const float* a_w, int* tok_of_slot, float* w_of_slot, int* slot_of, int* tile_e) {
    const int tid = opq((int)threadIdx.x);
    LAS int* cnt = (LAS int*)F.lds; LAS int* toff = cnt + 64; LAS int* ntr_l = toff + 64;
    if (tid < 64) cnt[tid] = (int)__hip_atomic_load(gcount + tid, RLX_AGENT);
    __syncthreads();
    if (tid == 0) { int o = 0; for (int e = 0; e < 64; ++e) { toff[e] = o; o += (cnt[e] + 255) >> 8; } ntr_l[0] = o; }
    __syncthreads();
    for (int ai = blockIdx.x * 512 + tid; ai < TK; ai += F.G * 512) { const int e = a_e[ai] & 63; int slot = T + toff[e] * 256 + a_pos[ai];
        slot = slot < T + MAXRT * 256 ? slot : T + MAXRT * 256 - 1;
        tok_of_slot[slot] = ai / 6; w_of_slot[slot] = a_w[ai]; slot_of[ai] = slot; }
    for (int t = blockIdx.x * 512 + tid; t < T; t += F.G * 512) { tok_of_slot[t] = t; w_of_slot[t] = 1.0f; }
    if (blockIdx.x < 64) { const int e = blockIdx.x, c = cnt[e], ntl = (c + 255) >> 8;
        for (int p = c + tid; p < ntl * 256; p += 512) { tok_of_slot[T + toff[e] * 256 + p] = 0; w_of_slot[T + toff[e] * 256 + p] = 0.f; }
        if (tid < ntl) tile_e[toff[e] + tid] = e; }
    if (blockIdx.x == 0 && tid == 0) tile_e[2048] = ntr_l[0];
    __syncthreads();
}

struct ProbGU {
    static constexpr bool GATHER = true;
    int ntiles, G, c; const int* tok_of_slot; const int* tile_e; const bf16* Wgu;
    __device__ __forceinline__ bool next(int i, pg8::Unit& u) const { const int L = i * G + c; if (L >= 2 * ntiles) return false; u.pm = L >> 1; u.pn = L & 1; return true; }
    __device__ __forceinline__ const char* bbase(const pg8::Unit& u) const { const int e = u.pm < 256 ? 64 : (ld_agent(tile_e + (u.pm - 256)) & 63);
        return (const char*)(Wgu + ((size_t)e * 512 + (size_t)u.pn * 256) * 1024); }
    __device__ __forceinline__ size_t abase(const pg8::Unit& u) const { return 0; }
    __device__ __forceinline__ unsigned arow(const pg8::Unit& u, int r) const { return (unsigned)tok_of_slot[u.pm * 256 + r] & 0xffffu; }
};
struct ProbDown {
    static constexpr bool GATHER = false;
    int ntiles, G, c; const int* tile_e; const bf16* Wd;
    __device__ __forceinline__ bool next(int i, pg8::Unit& u) const { const int L = i * G + c; if (L >= 4 * ntiles) return false; u.pm = L >> 2; u.pn = L & 3; return true; }
    __device__ __forceinline__ const char* bbase(const pg8::Unit& u) const { const int e = u.pm < 256 ? 64 : (ld_agent(tile_e + (u.pm - 256)) & 63);
        return (const char*)(Wd + ((size_t)e * 1024 + (size_t)u.pn * 256) * 256); }
    __device__ __forceinline__ size_t abase(const pg8::Unit& u) const { return (size_t)(u.pm * 256) * 512; }
    __device__ __forceinline__ unsigned arow(const pg8::Unit& u, int r) const { return (unsigned)(u.pm * 256 + r); }
};

__device__ __forceinline__ int clamp_slot(int v) { return v < T ? T : (v >= T + MAXRT * 256 ? T + MAXRT * 256 - 1 : v); }
__device__ __forceinline__ void phase_combine(const Frame& F, int l, const unsigned char* Y, const int* slot_of, bf16* xres, bf16* Hn, float* outf) {
    typedef float f32x2 __attribute__((ext_vector_type(2)));
    const int gw = F.vcu * NWAVES + F.wave, NGW = F.G * NWAVES, lane = (opq((int)threadIdx.x) & 63), c0 = 16 * lane;
    const float* modl = (const float*)(kws() + WS_MOD) + (size_t)l * 8 * 6144;
    int sl[2][6];
    int row = 2 * gw;
    if (row < T) {
#pragma unroll
        for (int r2 = 0; r2 < 2; ++r2)
#pragma unroll
            for (int k = 0; k < 6; ++k) sl[r2][k] = clamp_slot(ld_agent(slot_of + (row + r2) * 6 + k));
    }
    for (; row < T; row += 2 * NGW) { const int b = row / SEQ;
        v4u y[2][7]; v4u xw[2][2];
#pragma unroll
        for (int r2 = 0; r2 < 2; ++r2) {
#pragma unroll
            for (int k = 0; k < 6; ++k) y[r2][k] = __builtin_nontemporal_load((const GAS v4u*)(Y + (size_t)sl[r2][k] * 1024 + c0));
            y[r2][6] = __builtin_nontemporal_load((const GAS v4u*)(Y + (size_t)(row + r2) * 1024 + c0));
#pragma unroll
            for (int j = 0; j < 2; ++j) xw[r2][j] = *(const GAS v4u*)(xres + (size_t)(row + r2) * 1024 + c0 + 8 * j); }
        const int nrow = row + 2 * NGW;
        if (nrow < T) {
#pragma unroll
            for (int r2 = 0; r2 < 2; ++r2)
#pragma unroll
                for (int k = 0; k < 6; ++k) sl[r2][k] = clamp_slot(ld_agent(slot_of + (nrow + r2) * 6 + k));
        }
        f32x4 g[4];
#pragma unroll
        for (int j = 0; j < 4; ++j) g[j] = *(const f32x4*)(modl + (size_t)b * 6144 + 5 * 1024 + c0 + 4 * j) * 0.0625f;
        f32x4 x[2][4]; float ss[2];
#pragma unroll
        for (int r2 = 0; r2 < 2; ++r2) { f32x4 s[4];
#pragma unroll
            for (int j = 0; j < 4; ++j) s[j] = (f32x4){0.f, 0.f, 0.f, 0.f};
#pragma unroll
            for (int k = 0; k < 7; ++k) { const v4u w = y[r2][k];
                { const f32x2 a0 = __builtin_amdgcn_cvt_pk_f32_fp8((int)w.x, false), a1 = __builtin_amdgcn_cvt_pk_f32_fp8((int)w.x, true); s[0] += (f32x4){a0.x, a0.y, a1.x, a1.y}; }
                { const f32x2 a0 = __builtin_amdgcn_cvt_pk_f32_fp8((int)w.y, false), a1 = __builtin_amdgcn_cvt_pk_f32_fp8((int)w.y, true); s[1] += (f32x4){a0.x, a0.y, a1.x, a1.y}; }
                { const f32x2 a0 = __builtin_amdgcn_cvt_pk_f32_fp8((int)w.z, false), a1 = __builtin_amdgcn_cvt_pk_f32_fp8((int)w.z, true); s[2] += (f32x4){a0.x, a0.y, a1.x, a1.y}; }
                { const f32x2 a0 = __builtin_amdgcn_cvt_pk_f32_fp8((int)w.w, false), a1 = __builtin_amdgcn_cvt_pk_f32_fp8((int)w.w, true); s[3] += (f32x4){a0.x, a0.y, a1.x, a1.y}; } }
            { const v4u w0 = xw[r2][0], w1 = xw[r2][1];
              x[r2][0] = (f32x4){bflo(w0.x), bfhi(w0.x), bflo(w0.y), bfhi(w0.y)}; x[r2][1] = (f32x4){bflo(w0.z), bfhi(w0.z), bflo(w0.w), bfhi(w0.w)};
              x[r2][2] = (f32x4){bflo(w1.x), bfhi(w1.x), bflo(w1.y), bfhi(w1.y)}; x[r2][3] = (f32x4){bflo(w1.z), bfhi(w1.z), bflo(w1.w), bfhi(w1.w)}; }
            float q = 0.f;
#pragma unroll
            for (int j = 0; j < 4; ++j) { x[r2][j] += g[j] * s[j]; q += (x[r2][j].x * x[r2][j].x + x[r2][j].y * x[r2][j].y) + (x[r2][j].z * x[r2][j].z + x[r2][j].w * x[r2][j].w); }
            ss[r2] = q; }
        const float rstd0 = 1.0f / sqrtf(wave_sum(ss[0]) * (1.0f / 1024.0f) + EPS), rstd1 = 1.0f / sqrtf(wave_sum(ss[1]) * (1.0f / 1024.0f) + EPS);
        if (l == 0) {
            const float* ng = kin(3) + 1024; const float* m1 = (const float*)(kws() + WS_MOD) + (size_t)(8 + b) * 6144;
#pragma unroll
            for (int r2 = 0; r2 < 2; ++r2) { const float rs = r2 == 0 ? rstd0 : rstd1; unsigned hw[8], xo[8];
#pragma unroll
                for (int j = 0; j < 4; ++j) { xo[2 * j] = pk2(x[r2][j].x, x[r2][j].y); xo[2 * j + 1] = pk2(x[r2][j].z, x[r2][j].w);
                    const f32x4 g4 = *(const f32x4*)(ng + c0 + 4 * j), sc4 = *(const f32x4*)(m1 + 1024 + c0 + 4 * j), sh4 = *(const f32x4*)(m1 + c0 + 4 * j);
                    const f32x4 h = x[r2][j] * rs * g4 * (sc4 + 1.0f) + sh4; hw[2 * j] = pk2(h.x, h.y); hw[2 * j + 1] = pk2(h.z, h.w); }
                GAS v4u* xp = (GAS v4u*)(xres + (size_t)(row + r2) * 1024 + c0);
                xp[0] = (v4u){xo[0], xo[1], xo[2], xo[3]}; xp[1] = (v4u){xo[4], xo[5], xo[6], xo[7]};
                GAS v4u* hp = (GAS v4u*)(Hn + (size_t)(row + r2) * 1024 + c0);
                hp[0] = (v4u){hw[0], hw[1], hw[2], hw[3]}; hp[1] = (v4u){hw[4], hw[5], hw[6], hw[7]}; }
        } else {
            const float* fg = kin(28);
#pragma unroll
            for (int r2 = 0; r2 < 2; ++r2) { const float rs = r2 == 0 ? rstd0 : rstd1;
#pragma unroll
                for (int j = 0; j < 4; ++j) *(f32x4*)(outf + (size_t)(row + r2) * 1024 + c0 + 4 * j) = x[r2][j] * rs * *(const f32x4*)(fg + c0 + 4 * j); }
        }
    }
}

__device__ __forceinline__ void phase_spatial(const Frame& F, const Args& a, const bf16* Z, const bf16* Wsb, bf16* Gout, char* lds) {
    const int tid = opq((int)threadIdx.x), lane = tid & 63, wave = F.wave, r32 = lane & 31, hi = lane >> 5;
    LAS float* stats = (LAS float*)(F.lds + 144384);
    const float* ln_g = kin(15); const float* ln_b = kin(16); const float* b_s = kin(18);
    const int sr = tid >> 4, sc = (tid & 15) * 8;
    const int pb = wave & 3, ch = wave >> 2;
    LAS float* Sw = (LAS float*)(F.lds + wave * 16384);
    for (int chunk = F.vcu; chunk < T / 128; chunk += F.G) { const size_t R0 = (size_t)chunk * 128;
#pragma unroll 1
        for (int rr = 0; rr < 16; rr += 4) {
            v4u w[4][4];
#pragma unroll
            for (int r4 = 0; r4 < 4; ++r4) { const GAS v4u* vp = (const GAS v4u*)(Z + (R0 + wave * 16 + rr + r4) * 4096 + 2048) + lane;
#pragma unroll
                for (int j = 0; j < 4; ++j) w[r4][j] = vp[64 * j]; }
#pragma unroll
            for (int r4 = 0; r4 < 4; ++r4) { float s = 0.f;
#pragma unroll
                for (int j = 0; j < 4; ++j) s += ((bflo(w[r4][j].x) + bfhi(w[r4][j].x)) + (bflo(w[r4][j].y) + bfhi(w[r4][j].y))) + ((bflo(w[r4][j].z) + bfhi(w[r4][j].z)) + (bflo(w[r4][j].w) + bfhi(w[r4][j].w)));
                const float mean = wave_sum(s) * (1.0f / 2048.0f); float qq = 0.f;
#pragma unroll
                for (int j = 0; j < 4; ++j) { const unsigned ww[4] = {w[r4][j].x, w[r4][j].y, w[r4][j].z, w[r4][j].w};
#pragma unroll
                    for (int t = 0; t < 4; ++t) { const float d0 = bflo(ww[t]) - mean, d1 = bfhi(ww[t]) - mean; qq += d0 * d0 + d1 * d1; } }
                const float rstd = 1.0f / sqrtf(wave_sum(qq) * (1.0f / 2048.0f) + EPS);
                if (lane == 0) { const int q = wave * 16 + rr + r4; stats[2 * q] = mean; stats[2 * q + 1] = rstd; } }
        }
        __syncthreads();
#pragma unroll 1
        for (int g = 0; g < 8; ++g) {
            v4u uu[8];
#pragma unroll
            for (int i = 0; i < 8; ++i) uu[i] = *(const GAS v4u*)(Z + (R0 + 32 * pb + 4 * i + (lane >> 4)) * 4096 + g * 256 + 128 * ch + 8 * (lane & 15));
#pragma unroll
            for (int qt = 0; qt < 2; ++qt)
#pragma unroll
                for (int c2 = 0; c2 < 2; ++c2)
#pragma unroll
                    for (int hf = 0; hf < 2; ++hf) { const int ql = sr + 32 * hf, q = 64 * qt + ql, col = g * 256 + 128 * c2 + sc;
                        const v4u w = *(const GAS v4u*)(Z + (R0 + q) * 4096 + 2048 + col);
                        const float mean = stats[2 * q], rstd = stats[2 * q + 1];
                        const f32x4 lg0 = *(const f32x4*)(ln_g + col), lg1 = *(const f32x4*)(ln_g + col + 4), lb0 = *(const f32x4*)(ln_b + col), lb1 = *(const f32x4*)(ln_b + col + 4);
                        v4u o; o.x = pk2((bflo(w.x) - mean) * rstd * lg0.x + lb0.x, (bfhi(w.x) - mean) * rstd * lg0.y + lb0.y);
                        o.y = pk2((bflo(w.y) - mean) * rstd * lg0.z + lb0.z, (bfhi(w.y) - mean) * rstd * lg0.w + lb0.w);
                        o.z = pk2((bflo(w.z) - mean) * rstd * lg1.x + lb1.x, (bfhi(w.z) - mean) * rstd * lg1.y + lb1.y);
                        o.w = pk2((bflo(w.w) - mean) * rstd * lg1.z + lb1.z, (bfhi(w.w) - mean) * rstd * lg1.w + lb1.w);
                        *(LAS v4u*)(F.lds + (qt * 2 + c2) * 16384 + att::v_st(ql, sc)) = o; }
            __syncthreads();
            f32x16 o[4] = {};
#pragma unroll
            for (int qt = 0; qt < 2; ++qt) { bf16x8 pa[4];
#pragma unroll
                for (int ks = 0; ks < 4; ++ks) pa[ks] = *(const bf16x8*)(Wsb + ((size_t)g * 128 + 32 * pb + r32) * 128 + 64 * qt + 16 * ks + 8 * hi);
                att::pv_d0(o, (int)(uintptr_t)(F.lds + (qt * 2 + ch) * 16384) + att::v_rd_base(lane), pa[0], pa[1], pa[2], pa[3]); }
            __syncthreads();
#pragma unroll
            for (int r = 0; r < 16; ++r) { const int pl = att::crow(r, hi); const float bs = b_s[g * 128 + 32 * pb + pl];
#pragma unroll
                for (int d0 = 0; d0 < 4; ++d0) Sw[pl * 128 + 32 * d0 + r32] = o[d0][r] + bs; }
            asm volatile("s_waitcnt lgkmcnt(0)" ::: "memory");
#pragma unroll
            for (int i = 0; i < 8; ++i) { const int pl = 4 * i + (lane >> 4), cl = 8 * (lane & 15);
                const f32x4 s0 = *(const LAS f32x4*)(Sw + pl * 128 + cl), s1 = *(const LAS f32x4*)(Sw + pl * 128 + cl + 4);
                v4u ow; ow.x = pk2(bflo(uu[i].x) * s0.x, bfhi(uu[i].x) * s0.y); ow.y = pk2(bflo(uu[i].y) * s0.z, bfhi(uu[i].y) * s0.w);
                ow.z = pk2(bflo(uu[i].z) * s1.x, bfhi(uu[i].z) * s1.y); ow.w = pk2(bflo(uu[i].w) * s1.z, bfhi(uu[i].w) * s1.w);
                *(GAS v4u*)(Gout + (R0 + 32 * pb + pl) * 2048 + g * 256 + 128 * ch + cl) = ow; }
            __syncthreads();
        }
    }
}

#define ws kws()
#define GRID_BAR() do { XcdBarrier b_; b_.bar = (unsigned*)((gu32*)(kws() + WS_CTL) + CW_BAR); b_.x = xb_xcc_id(); b_.st = (volatile LAS unsigned*)(F.lds + MISC_OFF) + 8; xcd_barrier(b_); } while (0)
#define mod ((float*)(ws + WS_MOD))
#define A0 ((bf16*)kout())
#define XB ((bf16*)(ws + WS_A0))
#define Qb ((bf16*)(ws + WS_Q))
#define Kb ((bf16*)(ws + WS_K))
#define Vb ((bf16*)(ws + WS_V))
#define OS ((bf16*)(ws + WS_OS))
#define HM ((bf16*)(ws + WS_HMOE))
#define Yb ((bf16*)(ws + WS_Y))
#define Zb ((bf16*)(ws + WS_Z))
#define a_e ((int*)(ws + WS_AE))
#define a_pos ((int*)(ws + WS_APOS))
#define a_w ((float*)(ws + WS_AW))
#define tok_of_slot ((int*)(ws + WS_TOK))
#define w_of_slot ((float*)(ws + WS_WSLOT))
#define slot_of ((int*)(ws + WS_SLOTOF))
#define tile_e ((int*)(ws + WS_TILEE))
#define modl (mod + (size_t)l * 8 * 6144)

template <int l> __device__ __forceinline__ void layer_body(const Frame& F, const Args& a, char* ldsg) {
    gu32* ctl = (gu32*)(ws + WS_CTL);
#define modl (mod + (size_t)l * 8 * 6144)
        if (l == 0) {
            { pg8::ProbDense S; S.init(T, 3072, 1024, (const bf16*)(ws + WS_WQKV), F.G, (int)blockIdx.x);
              pg8::EpiQKV E{Qb, (size_t)(WS_K - WS_Q) / 2, (const float*)(ws + WS_COS), (const float*)(ws + WS_SIN), att::QSCALE};

#if PHMASK & 4
              for (int rep = 0; rep < REP_QKV; ++rep) pg8::gemm_phase<pg8::EpiQKV, pg8::ProbDense, true>(F.lds, A0, 1024, S, E);
#endif
            }
            GRID_BAR();
#if PHMASK & 8
            for (int rep = 0; rep < REP_ATT; ++rep) phase_attn(F, Qb, Kb, Vb, A0, ldsg);
#endif
            GRID_BAR();
        } else {
            { pg8::ProbDense S; S.init(T, 4096, 1024, (const bf16*)(ws + WS_WSGIN), F.G, (int)blockIdx.x);
              pg8::EpiBf16<1> E{Zb, 4096};

#if PHMASK & 32
              for (int rep = 0; rep < REP_SGIN; ++rep) pg8::gemm_phase<pg8::EpiBf16<1>, pg8::ProbDense, true>(F.lds, A0, 1024, S, E);
#endif
            }
            GRID_BAR();
#if PHMASK & 64
            for (int rep = 0; rep < REP_SPAT; ++rep) phase_spatial(F, a, Zb, (const bf16*)(ws + WS_WSB), A0, ldsg);
#endif
            GRID_BAR();
        }
        { const int Kp = l == 0 ? 1024 : 2048;
          pg8::ProbDense S; S.init(T, 1024, Kp, (const bf16*)(ws + (l == 0 ? WS_WO : WS_WSGOUT)), F.G, (int)blockIdx.x);
          pg8::EpiRes<l == 0> E{l == 0 ? (const void*)kin(0) : (const void*)XB, XB, modl + 2 * 1024};

#if PHMASK & 128
          pg8::gemm_phase<pg8::EpiRes<l == 0>, pg8::ProbDense, true>(F.lds, A0, Kp, S, E);
#endif
        }
        GRID_BAR();
#if PHMASK & 256
        phase_norm_router(F, XB, kin(4) + l * 1024, modl, (const bf16*)(ws + WS_WRP) + (size_t)l * 8 * 2 * 64 * 1024, (const float*)(ws + WS_RC) + l * 512, kin(21) + l * 64, A0, a_e, a_pos, a_w, ctl + CW_CNT + 64 * l);
#endif
        GRID_BAR();
#if PHMASK & 512
        for (int rep = 0; rep < REP_DISP; ++rep) phase_dispatch(F, ctl + CW_CNT + 64 * l, a_e, a_pos, a_w, tok_of_slot, w_of_slot, slot_of, tile_e);
#endif
        GRID_BAR();
        int ntr = ld_agent(tile_e + 2048); ntr = ntr < 0 ? 0 : (ntr > MAXRT ? MAXRT : ntr);
        const int xcd_ = F.vcu >> 5, idx_ = F.vcu & 31; const bool split_ = (l == 0) && (F.G == 256);
        const bool conv_ = split_ && idx_ >= 30 && xcd_ < 6;
        if (conv_) convert_moe_weights(F, 1, (bf16*)(ws + WS_WGU), 0, CV_SPLIT, ((xcd_ * 2 + (idx_ - 30)) * NWAVES + F.wave), 12 * NWAVES);
        else
        { ProbGU S{256 + ntr, split_ ? 244 : F.G, split_ ? F.vcu - 2 * (xcd_ < 6 ? xcd_ : 6) : F.vcu, tok_of_slot, tile_e, (const bf16*)(l == 0 ? (unsigned char*)kout() + CV_OUT_OFF : ws + WS_WGU)};
          pg8::EpiGU E{HM, w_of_slot};

#if PHMASK & 1024
          for (int rep = 0; rep < REP_GU; ++rep) pg8::gemm_phase<pg8::EpiGU, ProbGU, true>(F.lds, A0, 1024, S, E);
#endif
        }
        GRID_BAR();
        { ProbDown S{256 + ntr, F.G, F.vcu, tile_e, (const bf16*)(l == 0 ? (unsigned char*)kout() + CV_OUT_OFF + (WS_WD - WS_WGU) : ws + WS_WD)};
          pg8::EpiDown E{(unsigned char*)Yb};
#if PHMASK & 4096
          for (int rep = 0; rep < REP_DOWN; ++rep) pg8::gemm_phase<pg8::EpiDown, ProbDown, true>(F.lds, HM, 256, S, E);
#endif
        }
        GRID_BAR();
#if PHMASK & 8192
        phase_combine(F, l, (const unsigned char*)Yb, slot_of, XB, A0, kout());
        if (l == 0) convert_moe_weights(F, 1, (bf16*)(ws + WS_WGU), CV_SPLIT, CV_NITEMS, F.vcu * NWAVES + F.wave, F.G * NWAVES);
#endif
        GRID_BAR();
}

__global__ void __launch_bounds__(NWAVES * 64, 2) fwd(Args a) {
    extern __shared__ __attribute__((aligned(16))) unsigned char lds[];
    Frame F;
    F.lds = (LAS unsigned char*)lds;
    F.wave = __builtin_amdgcn_readfirstlane((int)threadIdx.x >> 6);
    F.G = gridDim.x; { const int bx = blockIdx.x; F.vcu = (F.G % 8 == 0) ? (bx % 8) * (F.G / 8) + bx / 8 : bx; }
    gu32* ctl = (gu32*)(ws + WS_CTL);
    for (int u = threadIdx.x; u < (LDS_BYTES - LDSCTL_OFF) / 4; u += NWAVES * 64) ((LAS unsigned*)(F.lds + LDSCTL_OFF))[u] = 0u;
    __syncthreads();
    volatile LAS unsigned* MISC = (volatile LAS unsigned*)(F.lds + MISC_OFF);
    (void)xcd_barrier_post((unsigned*)(ctl + CW_BAR), MISC + 8);


#if PHMASK & 1
    for (int rep = 0; rep < REP_PRO; ++rep) phase_prologue(F, a);
#endif
    GRID_BAR();
#if PHMASK & 2
    router_precompute(F);
    for (int rep = 0; rep < REP_NORM1; ++rep) phase_norm(F, kin(0), kin(3), mod, mod + 1024, A0);
#endif
    GRID_BAR();

    layer_body<0>(F, a, (char*)lds);
    layer_body<1>(F, a, (char*)lds);
}
#undef ws
#undef mod
#undef modl
#undef A0
#undef XB
#undef Qb
#undef Kb
#undef Vb
#undef OS
#undef HM
#undef Yb
#undef Zb
#undef a_e
#undef a_pos
#undef a_w
#undef tok_of_slot
#undef w_of_slot
#undef slot_of
#undef tile_e

extern "C" void kernel_launch(void* const* d_in, const int* in_sizes, int n_in, void* d_out, int out_size, void* d_ws, size_t ws_size, hipStream_t stream) {
    static int grid = 0;
    if (grid == 0) {
        if (n_in != 29 || out_size != T * D || ws_size < WS_END) { fprintf(stderr, "kernel_launch: unexpected shapes: n_in %d out %d ws %zu (need %zu)\n", n_in, out_size, ws_size, (size_t)WS_END); grid = -1; return; }
        int dev = 0, cus = 0, per_cu = 0;
        if (hipGetDevice(&dev) != hipSuccess || hipDeviceGetAttribute(&cus, hipDeviceAttributeMultiprocessorCount, dev) != hipSuccess) { grid = -1; return; }
        if (hipFuncSetAttribute((const void*)fwd, hipFuncAttributeMaxDynamicSharedMemorySize, LDS_BYTES) != hipSuccess) { fprintf(stderr, "kernel_launch: hipFuncSetAttribute failed\n"); grid = -1; return; }
        if (hipOccupancyMaxActiveBlocksPerMultiprocessor(&per_cu, (const void*)fwd, NWAVES * 64, LDS_BYTES) != hipSuccess || per_cu < 1)
            fprintf(stderr, "kernel_launch: note: occupancy query reports %d workgroups per CU\n", per_cu);
        (void)hipGetLastError();
        grid = cus;
    }
    if (grid < 0) return;
    if (hipMemsetAsync((char*)d_ws + WS_CTL, 0, CTL_ZERO_BYTES, stream) != hipSuccess) return;
    Args a{};
    for (int i = 0; i < 29; ++i) a.in[i] = (const float*)d_in[i];
    a.out = (float*)d_out; a.ws = (unsigned char*)d_ws;
    hipLaunchKernelGGL(fwd, dim3(grid), dim3(NWAVES * 64), LDS_BYTES, stream, a);
    const hipError_t le = hipPeekAtLastError();
    if (le != hipSuccess) fprintf(stderr, "kernel_launch: launch failed: %s\n", hipGetErrorName(le));
}
```
